# Optimizing an MI355X kernel written in HIP

```python
import jax, jax.numpy as jnp
from jax import lax
import numpy as np

D_MODEL = 1024
BATCH = 4
SEQ = 4096
DEPTH = 2
DEC_BATCH = 128
DEC_SEQ = 1
PAST_LEN = 16384
PAGE_SIZE = 128

CONV_WIDTH = D_MODEL
CONV_KERNEL = 31
CONV_BUF = CONV_KERNEL - 1
N_HEADS = 16
HEAD_DIM = 64
N_KV_HEADS = 2
GROUP = N_HEADS // N_KV_HEADS
ATTN_WIDTH = N_HEADS * HEAD_DIM
KV_WIDTH = N_KV_HEADS * HEAD_DIM
WINDOW = 128
BLOCK = 128
ROPE_DIM = HEAD_DIM // 4
ROPE_THETA = 500000.0
EPS = 1e-6
NEG = -1e30
IN_SIZES = (2 * CONV_WIDTH, CONV_WIDTH, ATTN_WIDTH, KV_WIDTH, KV_WIDTH, ATTN_WIDTH, D_MODEL, D_MODEL)
IN_COLS = sum(IN_SIZES)

kernel_name = "hybrid_conformer_swa_sink_gated_step"


def rms_norm(x, g):
    xf = x.astype(jnp.float32)
    y = xf * lax.rsqrt(jnp.mean(xf * xf, axis=-1, keepdims=True) + EPS)
    return (y * g.astype(jnp.float32)).astype(x.dtype)


def layer_norm(x, g, b):
    xf = x.astype(jnp.float32)
    mu = jnp.mean(xf, axis=-1, keepdims=True)
    var = jnp.mean(jnp.square(xf - mu), axis=-1, keepdims=True)
    y = (xf - mu) * lax.rsqrt(var + EPS)
    return (y * g.astype(jnp.float32) + b.astype(jnp.float32)).astype(x.dtype)


def partial_rope(x, pos):
    half = ROPE_DIM // 2
    inv = ROPE_THETA ** (-jnp.arange(0, ROPE_DIM, 2, dtype=jnp.float32) / ROPE_DIM)
    ang = pos.astype(jnp.float32)[:, None] * inv[None, :]
    cos = jnp.cos(ang)[None, :, None, :]
    sin = jnp.sin(ang)[None, :, None, :]
    xf = x.astype(jnp.float32)
    x1, x2, rest = xf[..., :half], xf[..., half:ROPE_DIM], xf[..., ROPE_DIM:]
    out = jnp.concatenate([x1 * cos - x2 * sin, x2 * cos + x1 * sin, rest], axis=-1)
    return out.astype(x.dtype)


def split_in(z):
    idx = np.cumsum(np.array(IN_SIZES))[:-1].tolist()
    return jnp.split(z, idx, axis=-1)


def sink_attention(q, k, v, mask, sinks):
    s = jnp.einsum('nbqkgd,nbskd->nbkgqs', q.astype(jnp.float32), k.astype(jnp.float32))
    s = s * (HEAD_DIM ** -0.5)
    s = jnp.where(mask[None, :, None, None], s, NEG)
    sk = sinks.astype(jnp.float32).reshape(1, 1, N_KV_HEADS, GROUP, 1, 1)
    m = jnp.maximum(jnp.max(s, axis=-1, keepdims=True), sk)
    p = jnp.exp(s - m)
    denom = jnp.sum(p, axis=-1, keepdims=True) + jnp.exp(sk - m)
    o = jnp.einsum('nbkgqs,nbskd->nbqkgd', p / denom, v.astype(jnp.float32))
    return o.astype(q.dtype)


def attend_prompt(q, k, v, sinks):
    n, t = q.shape[0], q.shape[1]
    nb = t // BLOCK
    qb = q.reshape(n, nb, BLOCK, N_KV_HEADS, GROUP, HEAD_DIM)
    kb = k.reshape(n, nb, BLOCK, N_KV_HEADS, HEAD_DIM)
    vb = v.reshape(n, nb, BLOCK, N_KV_HEADS, HEAD_DIM)
    zero = jnp.zeros_like(kb[:, :1])
    kk = jnp.concatenate([jnp.concatenate([zero, kb[:, :-1]], axis=1), kb], axis=2)
    vv = jnp.concatenate([jnp.concatenate([zero, vb[:, :-1]], axis=1), vb], axis=2)
    i = jnp.arange(BLOCK)[None, :, None]
    j = jnp.arange(2 * BLOCK)[None, None, :]
    blk = jnp.arange(nb)[:, None, None]
    diff = BLOCK + i - j
    kpos = (blk - 1) * BLOCK + j
    mask = (diff >= 0) & (diff < WINDOW) & (kpos >= 0)
    o = sink_attention(qb, kk, vv, mask, sinks)
    return o.reshape(n, t, ATTN_WIDTH), k[:, -WINDOW:], v[:, -WINDOW:]


def make_attend_sample(k_buf, v_buf):
    def attend_sample(q, k, v, sinks):
        n, t = q.shape[0], q.shape[1]
        kk = jnp.concatenate([k_buf, k], axis=1)
        vv = jnp.concatenate([v_buf, v], axis=1)
        qpos = PAST_LEN + jnp.arange(t)
        kpos = jnp.concatenate([PAST_LEN - WINDOW + jnp.arange(WINDOW), qpos])
        diff = qpos[:, None] - kpos[None, :]
        mask = ((diff >= 0) & (diff < WINDOW))[None]
        qb = q.reshape(n, 1, t, N_KV_HEADS, GROUP, HEAD_DIM)
        o = sink_attention(qb, kk[:, None], vv[:, None], mask, sinks)
        return o.reshape(n, t, ATTN_WIDTH), kk[:, -WINDOW:], vv[:, -WINDOW:]
    return attend_sample


def hybrid_layer(x, pos, conv_buf, attend, norm_g, w_in, conv_w, conv_b, ln_g, ln_b,
                 w_conv_out, sinks, w_attn_out, w_out):
    n, t, _ = x.shape
    h = rms_norm(x, norm_g)
    z = jnp.einsum('ntd,dc->ntc', h, w_in)
    glu, gate_a, q, k, v, gate_b, mg_a, mg_b = split_in(z)
    u = glu[..., :CONV_WIDTH] * jax.nn.sigmoid(glu[..., CONV_WIDTH:])
    full = jnp.concatenate([conv_buf, u], axis=1)
    c = lax.conv_general_dilated(full, conv_w[:, None, :], window_strides=(1,), padding='VALID',
                                 dimension_numbers=('NWC', 'WIO', 'NWC'),
                                 feature_group_count=CONV_WIDTH) + conv_b
    c = jax.nn.silu(layer_norm(c, ln_g, ln_b)) * jax.nn.silu(gate_a)
    y_a = jnp.einsum('ntc,cd->ntd', c, w_conv_out)
    new_conv = full[:, -CONV_BUF:]
    q = partial_rope(q.reshape(n, t, N_HEADS, HEAD_DIM), pos)
    k = partial_rope(k.reshape(n, t, N_KV_HEADS, HEAD_DIM), pos)
    v = v.reshape(n, t, N_KV_HEADS, HEAD_DIM)
    o, new_k, new_v = attend(q, k, v, sinks)
    y_b = jnp.einsum('nte,ed->ntd', o * jax.nn.silu(gate_b), w_attn_out)
    y = jax.nn.sigmoid(mg_a) * y_a + jax.nn.sigmoid(mg_b) * y_b
    return x + jnp.einsum('ntd,de->nte', y, w_out), new_conv, new_k, new_v


def setup_inputs(seed: int = 0) -> dict:
    key = jax.random.key(seed)
    ks = jax.random.split(key, 17)
    f = jnp.float32
    nrm = lambda k, shape, s: jax.random.normal(k, shape, f) * s
    return {
        "x_prompt": nrm(ks[0], (BATCH, SEQ, D_MODEL), 1.0),
        "x_sample": nrm(ks[1], (DEC_BATCH, DEC_SEQ, D_MODEL), 1.0),
        "state_conv": nrm(ks[2], (DEPTH, DEC_BATCH, CONV_BUF, CONV_WIDTH), 0.5),
        "cache_k_win": nrm(ks[3], (DEPTH, DEC_BATCH, WINDOW, N_KV_HEADS, HEAD_DIM), 1.0),
        "cache_v_win": nrm(ks[4], (DEPTH, DEC_BATCH, WINDOW, N_KV_HEADS, HEAD_DIM), 1.0),
        "norm_g": 1.0 + nrm(ks[5], (DEPTH, D_MODEL), 0.1),
        "w_in": nrm(ks[6], (DEPTH, D_MODEL, IN_COLS), D_MODEL ** -0.5),
        "conv_w": nrm(ks[7], (DEPTH, CONV_KERNEL, CONV_WIDTH), CONV_KERNEL ** -0.5),
        "conv_b": nrm(ks[8], (DEPTH, CONV_WIDTH), 0.02),
        "conv_ln_g": 1.0 + nrm(ks[9], (DEPTH, CONV_WIDTH), 0.1),
        "conv_ln_b": nrm(ks[10], (DEPTH, CONV_WIDTH), 0.02),
        "w_conv_out": nrm(ks[11], (DEPTH, CONV_WIDTH, D_MODEL), CONV_WIDTH ** -0.5),
        "attn_sinks": nrm(ks[12], (DEPTH, N_HEADS), 0.5),
        "w_attn_out": nrm(ks[13], (DEPTH, ATTN_WIDTH, D_MODEL), ATTN_WIDTH ** -0.5),
        "w_out": nrm(ks[14], (DEPTH, D_MODEL, D_MODEL), D_MODEL ** -0.5),
        "final_norm_g": 1.0 + nrm(ks[15], (D_MODEL,), 0.1),
    }


def reference(x_prompt, x_sample, state_conv, cache_k_win, cache_v_win, norm_g, w_in, conv_w,
              conv_b, conv_ln_g, conv_ln_b, w_conv_out, attn_sinks, w_attn_out, w_out, final_norm_g):
    t_p = x_prompt.shape[1]
    t_s = x_sample.shape[1]
    pos_p = jnp.arange(t_p)
    pos_s = PAST_LEN + jnp.arange(t_s)
    hp, hs = x_prompt, x_sample
    conv_p, k_p, v_p, conv_s, k_s, v_s = [], [], [], [], [], []
    for l in range(DEPTH):
        params = (norm_g[l], w_in[l], conv_w[l], conv_b[l], conv_ln_g[l], conv_ln_b[l],
                  w_conv_out[l], attn_sinks[l], w_attn_out[l], w_out[l])
        zero_buf = jnp.zeros((hp.shape[0], CONV_BUF, CONV_WIDTH), hp.dtype)
        hp, c1, k1, v1 = hybrid_layer(hp, pos_p, zero_buf, attend_prompt, *params)
        hs, c2, k2, v2 = hybrid_layer(hs, pos_s, state_conv[l],
                                      make_attend_sample(cache_k_win[l], cache_v_win[l]), *params)
        conv_p.append(c1); k_p.append(k1); v_p.append(v1)
        conv_s.append(c2); k_s.append(k2); v_s.append(v2)
    y_prompt = rms_norm(hp, final_norm_g)
    y_sample = rms_norm(hs, final_norm_g)
    new_conv_prompt = jnp.stack(conv_p)
    new_k_prompt = jnp.stack(k_p)
    new_v_prompt = jnp.stack(v_p)
    new_conv_sample = jnp.stack(conv_s)
    new_k_sample = jnp.stack(k_s)
    new_v_sample = jnp.stack(v_s)
    return (y_prompt, y_sample, new_conv_prompt, new_k_prompt, new_v_prompt,
            new_conv_sample, new_k_sample, new_v_sample)
```

```cpp
#include <hip/hip_runtime.h>
#include <hip/hip_cooperative_groups.h>
#include <cstdio>
#include <cstdint>
namespace cg = cooperative_groups;
#ifndef REP_A
#define REP_A 1
#endif
#ifndef REP_C
#define REP_C 1
#endif
#ifndef REP_B1
#define REP_B1 1
#endif
#ifndef REP_B2
#define REP_B2 1
#endif
#ifndef DUMMY_CONV
#define DUMMY_CONV 0
#endif
#ifndef REP_D
#define REP_D 1
#endif
#ifndef DUMMY_SAMP
#define DUMMY_SAMP 0
#endif
#ifndef REP_F
#define REP_F 1
#endif
#ifndef REP_B
#define REP_B 1
#endif
#ifndef REP_B_MASK
#define REP_B_MASK 7
#endif
#ifndef REP_P0
#define REP_P0 1
#endif

constexpr int DM = 1024, SEQ = 4096, MP = 16384, MS = 128, MR = MP + MS, MPAD = 16640, INC = 7424;
constexpr float EPS = 1e-6f;
constexpr float QSCALE = 0.125f * 1.4426950408889634f, LOG2E = 1.4426950408889634f;
constexpr size_t O_YP = 0, O_YS = (size_t)MP * DM, O_NCP = O_YS + (size_t)MS * DM, O_NKP = O_NCP + 2 * 4 * 30 * 1024, O_NVP = O_NKP + 2 * 4 * 128 * 128,
                 O_NCS = O_NVP + 2 * 4 * 128 * 128, O_NKS = O_NCS + (size_t)2 * 128 * 30 * 1024, O_NVS = O_NKS + (size_t)2 * 128 * 128 * 128, O_END = O_NVS + (size_t)2 * 128 * 128 * 128;
constexpr size_t RB = (size_t)MPAD * DM * 2;
constexpr size_t WS_SUMSQ = 0;
constexpr size_t WS_CNT = 768 * 1024 + 16384;
constexpr size_t WS_BAR = 768 * 1024;
constexpr size_t WS_ROPE = 256 * 1024;
constexpr size_t WS_XN = 1 << 20, WS_U = WS_XN + RB, WS_GA = WS_U + RB, WS_Q = WS_GA + RB, WS_GB = WS_Q + RB, WS_D1 = WS_GB + RB, WS_KV = WS_D1 + RB;
constexpr size_t WS_WIN = WS_KV + (size_t)MPAD * 256 * 2, WS_WCA = WS_WIN + (size_t)2 * INC * DM * 2, WS_WO = WS_WCA + (size_t)2 * DM * 2048 * 2, WS_END = WS_WO + (size_t)2 * DM * DM * 2;
static_assert(WS_END <= 268435456, "d_ws map exceeds 256 MiB");
static_assert(3 * MPAD * 4 <= WS_ROPE && WS_ROPE + 4097 * 16 * 4 <= WS_XN, "small regions");

__device__ __forceinline__ int fresh_tid(int wave) { int l; asm volatile("v_mbcnt_lo_u32_b32 %0, -1, 0\n\tv_mbcnt_hi_u32_b32 %0, -1, %0" : "=v"(l)); return wave * 64 + l; }
namespace pg8 {
#define PG8_LAS __attribute__((address_space(3)))
typedef unsigned short bf16_t;
typedef short bf16x8 __attribute__((ext_vector_type(8)));
typedef float f32x4 __attribute__((ext_vector_type(4)));
typedef unsigned u32x4 __attribute__((ext_vector_type(4)));
constexpr int BM = 256, BK = 64, HALF = 128, HTB = HALF * BK * 2  , STAGE_BYTES = 8 * HTB, NXCD = 8, WGM = 8;

__host__ __device__ __forceinline__ int lds_byte(int r, int c) { const int st = (r >> 4) * 2 + (c >> 5), rr = r & 15, cc = c & 31, ob = rr * 64 + cc * 2; return st * 1024 + (ob ^ (((ob >> 9) & 1) << 5)); }
__host__ __device__ __forceinline__ void stage_rc(int b, int& R, int& C) { const int st = b / 1024, sb = b % 1024, swz = sb ^ (((sb >> 9) & 1) << 5); R = (st >> 1) * 16 + swz / 64; C = (st & 1) * 32 + (swz % 64) / 2; }
__host__ __device__ __forceinline__ int perm32(int rho) { const int n = rho >> 4, i = rho & 15; return 8 * (i >> 2) + 4 * n + (i & 3); }

struct Unit { int pm, pn; };
struct Gemm { const bf16_t* A; const bf16_t* A2; const bf16_t* Bt; int M, N, K, lda, nth; };

struct StaticOrder {
    int nM, nN, nwg, G, c;
    __host__ __device__ void init(int M, int N, int G_, int c_) { nM = M / BM; nN = N / BM; nwg = nM * nN; G = G_; c = c_; }
    __host__ __device__ bool next(int i, Unit& u) const {
        const long L = (long)i * G + c; if (L >= nwg) return false;
        int wgid = (int)L; { const int q = nwg / NXCD, r = nwg % NXCD, xcd = wgid % NXCD, off = wgid / NXCD; wgid = (xcd < r ? xcd * (q + 1) : r * (q + 1) + (xcd - r) * q) + off; }
        const int nig = WGM * nN, gid = wgid / nig, fm = gid * WGM, gsz = (nM - fm) < WGM ? (nM - fm) : WGM;
        u.pm = fm + ((wgid % nig) % gsz); u.pn = (wgid % nig) / gsz; return true;
    }
    __device__ __forceinline__ void a_ready(const Unit&) const {}
    __device__ __forceinline__ void done(const Unit&) const {}
};


template <class Epi, class Sched, bool ALIGN_EPI = false, bool SP2 = false, bool LAUNDER = true>
__device__ __forceinline__ void gemm_phase(PG8_LAS unsigned char* lds, const Gemm g, const Sched& S, const Epi& E, int wave_id) {
    int tid = fresh_tid(wave_id);
    asm volatile("" : "+v"(tid));
    const int wid = __builtin_amdgcn_readfirstlane(tid >> 6), lane = tid & 63, wr = wid >> 2, wc = wid & 3, fr = lane & 15, fq = lane >> 4;
    const int K = g.K, nt = K / BK, lda = g.lda, nth = g.nth;
    unsigned voffA[2], voffB[2];
#pragma unroll
    for (int i = 0; i < 2; ++i) { int R, C; stage_rc(tid * 16 + i * 8192, R, C); const int Rb = Epi::PERM ? ((R & ~31) + perm32(R & 31)) : R;
        voffA[i] = (unsigned)(R * lda + C) * 2u; voffB[i] = (unsigned)(Rb * K + C) * 2u; }
    const size_t kstep = (size_t)(BK * 2);
    const size_t hstepB = (size_t)HALF * K * 2, hstepA = (size_t)HALF * lda * 2;
    const size_t tstepB = 2 * hstepB, tstepA = 2 * hstepA;
    const unsigned ldsw = (unsigned)wid * 1024u;
    const int aoff = lds_byte(wr * 64 + fr, fq * 8), boff = lds_byte(wc * 32 + fr, fq * 8);
#define PG8_SA(b, h) (((b) * 2 + (h)) * HTB)
#define PG8_SB(b, h) ((4 + (b) * 2 + (h)) * HTB)
#define PG8_STAGE(bufoff, gbase, voff) do { _Pragma("unroll") for (int _i = 0; _i < 2; ++_i) \
        __builtin_amdgcn_global_load_lds((const unsigned*)((const char*)(gbase) + (voff)[_i]), (PG8_LAS unsigned*)(lds + (bufoff) + ldsw + _i * 8192), 16, 0, 0); } while (0)
#define PG8_LDA(dst, b, h) do { _Pragma("unroll") for (int m = 0; m < 4; ++m) _Pragma("unroll") for (int k = 0; k < 2; ++k) dst[m][k] = *(const PG8_LAS bf16x8*)(lds + PG8_SA(b, h) + aoff + m * 2048 + k * 1024); } while (0)
#define PG8_LDB(dst, b, h) do { _Pragma("unroll") for (int n = 0; n < 2; ++n) _Pragma("unroll") for (int k = 0; k < 2; ++k) dst[n][k] = *(const PG8_LAS bf16x8*)(lds + PG8_SB(b, h) + boff + n * 2048 + k * 1024); } while (0)
#define PG8_MMA(ai, bj, At, Bt) do { __builtin_amdgcn_s_setprio(1); _Pragma("unroll") for (int m = 0; m < 4; ++m) _Pragma("unroll") for (int n = 0; n < 2; ++n) _Pragma("unroll") for (int k = 0; k < 2; ++k) \
        acc[ai][bj][m][n] = __builtin_amdgcn_mfma_f32_16x16x32_bf16(Bt[n][k], At[m][k], acc[ai][bj][m][n], 0, 0, 0); __builtin_amdgcn_s_setprio(0); } while (0)
#define PG8_WAIT_V(n) asm volatile("s_waitcnt vmcnt(" #n ")" ::: "memory")
#define PG8_WAIT_L(n) asm volatile("s_waitcnt lgkmcnt(" #n ")" ::: "memory")
#define PG8_BAR __builtin_amdgcn_s_barrier()
#define PG8_SCHED __builtin_amdgcn_sched_barrier(0)
    Unit cur, nxt; int ui = 0;
    if (!S.next(0, cur)) return;
    f32x4 acc[2][2][4][2];
#pragma unroll
    for (int a = 0; a < 2; ++a)
#pragma unroll
        for (int b = 0; b < 2; ++b)
#pragma unroll
            for (int m = 0; m < 4; ++m)
#pragma unroll
                for (int n = 0; n < 2; ++n) acc[a][b][m][n] = (f32x4){0.f, 0.f, 0.f, 0.f};
    bf16x8 At[4][2], B0[2][2], B1[2][2];
    const char* cA = (const char*)g.A + (size_t)cur.pm * tstepA; const char* cB = (const char*)g.Bt + (size_t)cur.pn * tstepB;
    S.a_ready(cur);
    if constexpr (SP2) {
        PG8_STAGE(PG8_SB(0, 0), cB, voffB); PG8_STAGE(PG8_SB(0, 1), cB + hstepB, voffB); PG8_STAGE(PG8_SA(0, 0), cA, voffA); PG8_STAGE(PG8_SA(0, 1), cA + hstepA, voffA);
        if (wr == 1) PG8_BAR;
        PG8_WAIT_V(2); PG8_BAR;
        PG8_STAGE(PG8_SB(1, 0), cB + kstep, voffB); PG8_STAGE(PG8_SA(1, 0), cA + kstep, voffA); PG8_STAGE(PG8_SB(1, 1), cB + hstepB + kstep, voffB);
        PG8_WAIT_V(6); PG8_BAR;
    } else {
        PG8_STAGE(PG8_SB(0, 0), cB, voffB); PG8_STAGE(PG8_SA(0, 0), cA, voffA); PG8_STAGE(PG8_SB(0, 1), cB + hstepB, voffB); PG8_STAGE(PG8_SA(0, 1), cA + hstepA, voffA);
        if (wr == 1) PG8_BAR;
        PG8_WAIT_V(4); PG8_BAR;
        PG8_STAGE(PG8_SB(1, 0), cB + kstep, voffB); PG8_STAGE(PG8_SA(1, 0), cA + kstep, voffA); PG8_STAGE(PG8_SB(1, 1), cB + hstepB + kstep, voffB);
        PG8_WAIT_V(6); PG8_BAR;
    }
    for (;;) {
        const bool has_next = S.next(ui + 1, nxt);
        const char* nA = has_next ? (const char*)g.A + (size_t)nxt.pm * tstepA : cA; const char* nB = has_next ? (const char*)g.Bt + (size_t)nxt.pn * tstepB : cB;
        const char* cA2 = (const char*)g.A2 + (size_t)cur.pm * tstepA - (size_t)nth * kstep;
        for (int t = 0; t < nt; t += 2) {
            const bool last = (t == nt - 2);
            if constexpr (Epi::MID) { if (t == nth) E.mid(acc, cur, wr, wc, fr, fq); }
            const char* a1 = (t < nth ? cA : cA2) + (size_t)(t + 1) * kstep;
            const char* a2 = last ? nA : (t + 2 < nth ? cA : cA2) + (size_t)(t + 2) * kstep; const char* b2 = last ? nB : cB + (size_t)(t + 2) * kstep;
            const char* a3 = a2 + kstep; const char* b3 = b2 + kstep;
            if (last && has_next) S.a_ready(nxt);
            if constexpr (SP2) {
            PG8_LDB(B0, 0, 0); PG8_LDB(B1, 0, 1); PG8_SCHED; PG8_LDA(At, 0, 0); PG8_STAGE(PG8_SA(1, 1), a1 + hstepA, voffA);
            PG8_WAIT_V(8); PG8_WAIT_L(0); PG8_BAR; PG8_MMA(0, 0, At, B0); PG8_MMA(0, 1, At, B1); PG8_BAR; PG8_SCHED;
            PG8_LDA(At, 0, 1); PG8_STAGE(PG8_SB(0, 0), b2, voffB); PG8_STAGE(PG8_SB(0, 1), b2 + hstepB, voffB); PG8_STAGE(PG8_SA(0, 0), a2, voffA);
            PG8_WAIT_V(8); PG8_WAIT_L(0); PG8_BAR; PG8_MMA(1, 0, At, B0); PG8_MMA(1, 1, At, B1); PG8_BAR; PG8_SCHED;
            PG8_LDB(B0, 1, 0); PG8_LDB(B1, 1, 1); PG8_SCHED; PG8_LDA(At, 1, 0); PG8_STAGE(PG8_SA(0, 1), a2 + hstepA, voffA);
            PG8_WAIT_V(8); PG8_WAIT_L(0); PG8_BAR; PG8_MMA(0, 0, At, B0); PG8_MMA(0, 1, At, B1); PG8_BAR; PG8_SCHED;
            PG8_LDA(At, 1, 1); PG8_STAGE(PG8_SB(1, 0), b3, voffB); PG8_STAGE(PG8_SB(1, 1), b3 + hstepB, voffB); PG8_STAGE(PG8_SA(1, 0), a3, voffA);
            PG8_WAIT_V(8); PG8_WAIT_L(0); PG8_BAR; PG8_MMA(1, 0, At, B0); PG8_MMA(1, 1, At, B1); PG8_BAR; PG8_SCHED;
            } else {
            PG8_LDB(B0, 0, 0); PG8_SCHED; PG8_LDA(At, 0, 0); PG8_STAGE(PG8_SA(1, 1), a1 + hstepA, voffA);
            PG8_WAIT_L(8); PG8_BAR; PG8_WAIT_L(0); PG8_MMA(0, 0, At, B0); PG8_BAR; PG8_SCHED;
            PG8_LDB(B1, 0, 1); PG8_STAGE(PG8_SB(0, 0), b2, voffB);
            PG8_BAR; PG8_WAIT_L(0); PG8_MMA(0, 1, At, B1); PG8_BAR;
            PG8_LDA(At, 0, 1); PG8_STAGE(PG8_SA(0, 0), a2, voffA);
            PG8_BAR; PG8_WAIT_L(0); PG8_MMA(1, 0, At, B0); PG8_BAR; PG8_SCHED;
            PG8_STAGE(PG8_SB(0, 1), b2 + hstepB, voffB);
            PG8_WAIT_V(6); PG8_BAR; PG8_MMA(1, 1, At, B1); PG8_BAR;
            PG8_LDB(B0, 1, 0); PG8_SCHED; PG8_LDA(At, 1, 0); PG8_STAGE(PG8_SA(0, 1), a2 + hstepA, voffA);
            PG8_WAIT_L(8); PG8_BAR; PG8_WAIT_L(0); PG8_MMA(0, 0, At, B0); PG8_BAR; PG8_SCHED;
            PG8_LDB(B1, 1, 1); PG8_STAGE(PG8_SB(1, 0), b3, voffB);
            PG8_BAR; PG8_WAIT_L(0); PG8_MMA(0, 1, At, B1); PG8_BAR;
            PG8_LDA(At, 1, 1); PG8_STAGE(PG8_SA(1, 0), a3, voffA);
            PG8_BAR; PG8_WAIT_L(0); PG8_MMA(1, 0, At, B0); PG8_BAR; PG8_SCHED;
            PG8_STAGE(PG8_SB(1, 1), b3 + hstepB, voffB);
            PG8_WAIT_V(6); PG8_BAR; PG8_MMA(1, 1, At, B1); PG8_BAR;
            }
        }
        if constexpr (ALIGN_EPI) { if (wr == 0) PG8_BAR; }
        if constexpr (!Epi::AFTER_DRAIN) { E(acc, cur, wr, wc, fr, fq); S.done(cur); }
        if (!has_next) break;
#pragma unroll
        for (int a = 0; a < 2; ++a)
#pragma unroll
            for (int b = 0; b < 2; ++b)
#pragma unroll
                for (int m = 0; m < 4; ++m)
#pragma unroll
                    for (int n = 0; n < 2; ++n) acc[a][b][m][n] = (f32x4){0.f, 0.f, 0.f, 0.f};
        cur = nxt; cA = nA; cB = nB; ++ui;
        if constexpr (ALIGN_EPI) { if (wr == 1) PG8_BAR; }
    }
    PG8_WAIT_V(0);
    if constexpr (!ALIGN_EPI) { if (wr == 0) PG8_BAR; }
    PG8_BAR;
    if constexpr (Epi::AFTER_DRAIN) { E.fused(acc, cur, wr, wc, fr, fq, lds, wid, lane); S.done(cur); }
#undef PG8_SA
#undef PG8_SB
#undef PG8_STAGE
#undef PG8_LDA
#undef PG8_LDB
#undef PG8_MMA
#undef PG8_WAIT_V
#undef PG8_WAIT_L
#undef PG8_BAR
#undef PG8_SCHED
}
}

#define LAS __attribute__((address_space(3)))
typedef unsigned short bf16_t;
typedef float f32x4 __attribute__((ext_vector_type(4)));
typedef float f32x2 __attribute__((ext_vector_type(2)));
typedef float f32x16 __attribute__((ext_vector_type(16)));
typedef unsigned u32x4 __attribute__((ext_vector_type(4)));
typedef unsigned u32x2 __attribute__((ext_vector_type(2)));
typedef short bf16x8 __attribute__((ext_vector_type(8)));
typedef __bf16 bf16x2_t __attribute__((ext_vector_type(2)));
template <class T> __device__ __forceinline__ T* boff(T* base, unsigned bytes) { return (T*)((char*)base + bytes); }
template <class T> __device__ __forceinline__ const T* boff(const T* base, unsigned bytes) { return (const T*)((const char*)base + bytes); }
__device__ __forceinline__ unsigned pk2(float lo, float hi) { f32x2 v = {lo, hi}; bf16x2_t b = __builtin_convertvector(v, bf16x2_t); return __builtin_bit_cast(unsigned, b); }
__device__ __forceinline__ u32x4 pack8(f32x4 a, f32x4 b) { u32x4 w; w.x = pk2(a[0], a[1]); w.y = pk2(a[2], a[3]); w.z = pk2(b[0], b[1]); w.w = pk2(b[2], b[3]); return w; }
__device__ __forceinline__ float bf_lo(unsigned w) { return __uint_as_float(w << 16); }
__device__ __forceinline__ float bf_hi(unsigned w) { return __uint_as_float(w & 0xffff0000u); }
__device__ __forceinline__ void unpack8(u32x4 w, f32x4& a, f32x4& b) { a = (f32x4){bf_lo(w.x), bf_hi(w.x), bf_lo(w.y), bf_hi(w.y)}; b = (f32x4){bf_lo(w.z), bf_hi(w.z), bf_lo(w.w), bf_hi(w.w)}; }
__device__ __forceinline__ float sigmoidf_(float x) { return __builtin_amdgcn_rcpf(1.0f + __expf(-x)); }
__device__ __forceinline__ float siluf_(float x) { return x * sigmoidf_(x); }
__device__ __forceinline__ f32x4 sig4(f32x4 v) { return (f32x4){sigmoidf_(v[0]), sigmoidf_(v[1]), sigmoidf_(v[2]), sigmoidf_(v[3])}; }
__device__ __forceinline__ f32x4 silu4(f32x4 v) { return (f32x4){siluf_(v[0]), siluf_(v[1]), siluf_(v[2]), siluf_(v[3])}; }
__device__ __forceinline__ float rdlane(float v, int l) { return __uint_as_float((unsigned)__builtin_amdgcn_readlane((int)__float_as_uint(v), l)); }
template <int M> __device__ __forceinline__ float swz_xor(float v) { static_assert(M >= 1 && M <= 16, "swz_xor"); return __uint_as_float((unsigned)__builtin_amdgcn_ds_swizzle((int)__float_as_uint(v), (M << 10) | 0x1f)); }
__device__ __forceinline__ float sum_x32(float v) { auto r = __builtin_amdgcn_permlane32_swap(__float_as_uint(v), __float_as_uint(v), false, false); return __uint_as_float(r[0]) + __uint_as_float(r[1]); }
__device__ __forceinline__ float max_x32(float v) { auto r = __builtin_amdgcn_permlane32_swap(__float_as_uint(v), __float_as_uint(v), false, false); return fmaxf(__uint_as_float(r[0]), __uint_as_float(r[1])); }
__device__ __forceinline__ float get_x32(float v, bool upper) { auto r = __builtin_amdgcn_permlane32_swap(__float_as_uint(v), __float_as_uint(v), false, false); return __uint_as_float(upper ? r[0] : r[1]); }
__device__ __forceinline__ float wave_sum(float v) { v += swz_xor<1>(v); v += swz_xor<2>(v); v += swz_xor<4>(v); v += swz_xor<8>(v); v += swz_xor<16>(v); return sum_x32(v); }
__device__ __forceinline__ float wave_max(float v) { v = fmaxf(v, swz_xor<1>(v)); v = fmaxf(v, swz_xor<2>(v)); v = fmaxf(v, swz_xor<4>(v)); v = fmaxf(v, swz_xor<8>(v)); v = fmaxf(v, swz_xor<16>(v)); return max_x32(v); }

struct EpiIn {
    static constexpr bool PERM = true, AFTER_DRAIN = false, MID = false;
    unsigned char* ws; float* out; int l;
    __device__ __forceinline__ void rope8(f32x4& a, f32x4& b, const float* tab, bool doit, bool second) const {
        f32x4 pa, pb;
#pragma unroll
        for (int e = 0; e < 4; ++e) { pa[e] = swz_xor<16>(a[e]); pb[e] = swz_xor<16>(b[e]); }
        if (doit) {
            const f32x4 c0 = *(const f32x4*)(tab), c1 = *(const f32x4*)(tab + 4), s0 = *(const f32x4*)(tab + 8), s1 = *(const f32x4*)(tab + 12);
            if (second) { a = a * c0 + pa * s0; b = b * c1 + pb * s1; }
            else        { a = a * c0 - pa * s0; b = b * c1 - pb * s1; }
        }
    }
    __device__ __forceinline__ void operator()(const f32x4 (&acc)[2][2][4][2], const pg8::Unit& u, int wr, int wc, int fr, int fq) const {
        bf16_t* U = (bf16_t*)(ws + WS_U); bf16_t* GA = (bf16_t*)(ws + WS_GA); bf16_t* Q = (bf16_t*)(ws + WS_Q); bf16_t* KV = (bf16_t*)(ws + WS_KV); bf16_t* GB = (bf16_t*)(ws + WS_GB);
        bf16_t* MGR = (bf16_t*)out; bf16_t* MGB = MGR + (size_t)MR * DM;
        const float* sumsq = (const float*)(ws + WS_SUMSQ) + l * MPAD; const float* rope = (const float*)(ws + WS_ROPE);
        float* ncp = out + O_NCP + (size_t)l * 4 * 30 * 1024; float* nkp = out + O_NKP + (size_t)l * 4 * 128 * 128; float* nvp = out + O_NVP + (size_t)l * 4 * 128 * 128;
        float* ncs = out + O_NCS + (size_t)l * 128 * 30 * 1024; float* nks = out + O_NKS + (size_t)l * 128 * 128 * 128; float* nvs = out + O_NVS + (size_t)l * 128 * 128 * 128;
        const int pn = u.pn, cl = wc * 32 + 8 * fq;
        const bool ropelane = ((wc & 1) == 0) && (fq < 2), second = (fq & 1) != 0;
        float rsv[8];
#pragma unroll
        for (int i = 0; i < 8; ++i) rsv[i] = *boff(sumsq, (unsigned)(u.pm * 256 + (i >> 2) * 128 + wr * 64 + (i & 3) * 16 + fr) * 4u);
#pragma unroll
        for (int ai = 0; ai < 2; ++ai)
#pragma unroll
            for (int m = 0; m < 4; ++m) {
                const int row = u.pm * 256 + ai * 128 + wr * 64 + m * 16 + fr;
                const bool ok = row < MR;
                const float rs = rsqrtf(rsv[ai * 4 + m] * (1.0f / DM) + EPS);
                f32x4 v00 = acc[ai][0][m][0] * rs, v01 = acc[ai][0][m][1] * rs, v10 = acc[ai][1][m][0] * rs, v11 = acc[ai][1][m][1] * rs;
                const int pos = row & (SEQ - 1), b = row >> 12, sb = row - MP;
                if (pn < 8) {
                    const int col = 128 * pn + cl;
                    v00 = v00 * sig4(v10); v01 = v01 * sig4(v11);
                    if (ok) *(u32x4*)boff(U, (unsigned)(row * DM + col) * 2u) = pack8(v00, v01);
                    if (row < MP) { if (pos >= SEQ - 30) { float* o = boff(ncp, (unsigned)((b * 30 + pos - (SEQ - 30)) * DM + col) * 4u); *(f32x4*)o = v00; *(f32x4*)(o + 4) = v01; } }
                    else if (ok) { float* o = boff(ncs, (unsigned)((sb * 30 + 29) * DM + col) * 4u); *(f32x4*)o = v00; *(f32x4*)(o + 4) = v01; }
                } else if (pn < 12) {
                    const int col = 256 * (pn - 8) + cl;
                    if (ok) { bf16_t* o = boff(GA, (unsigned)(row * DM + col) * 2u); *(u32x4*)o = pack8(silu4(v00), silu4(v01)); *(u32x4*)(o + 128) = pack8(silu4(v10), silu4(v11)); }
                } else if (pn < 16) {
                    const int col = 256 * (pn - 12) + cl;
                    const float* tab = boff(rope, (unsigned)(row < MP ? pos : SEQ) * 64u);
                    rope8(v00, v01, tab, ropelane, second); rope8(v10, v11, tab, ropelane, second);
                    v00 *= QSCALE; v01 *= QSCALE; v10 *= QSCALE; v11 *= QSCALE;
                    if (ok) { bf16_t* o = boff(Q, (unsigned)(row * DM + col) * 2u); *(u32x4*)o = pack8(v00, v01); *(u32x4*)(o + 128) = pack8(v10, v11); }
                } else if (pn == 16) {
                    const float* tab = boff(rope, (unsigned)(row < MP ? pos : SEQ) * 64u);
                    rope8(v00, v01, tab, ropelane, second);
                    if (ok) { bf16_t* o = boff(KV, (unsigned)(row * 256 + cl) * 2u); *(u32x4*)o = pack8(v00, v01); *(u32x4*)(o + 128) = pack8(v10, v11); }
                    if (row < MP) { if (pos >= SEQ - 128) { const unsigned o = (unsigned)((b * 128 + pos - (SEQ - 128)) * 128 + cl) * 4u; float* ok_ = boff(nkp, o); float* ov_ = boff(nvp, o);
                            *(f32x4*)ok_ = v00; *(f32x4*)(ok_ + 4) = v01; *(f32x4*)ov_ = v10; *(f32x4*)(ov_ + 4) = v11; } }
                    else if (ok) { const unsigned o = (unsigned)((sb * 128 + 127) * 128 + cl) * 4u; float* ok_ = boff(nks, o); float* ov_ = boff(nvs, o);
                            *(f32x4*)ok_ = v00; *(f32x4*)(ok_ + 4) = v01; *(f32x4*)ov_ = v10; *(f32x4*)(ov_ + 4) = v11; }
                } else if (pn < 21) {
                    const int col = 256 * (pn - 17) + cl;
                    if (ok) { bf16_t* o = boff(GB, (unsigned)(row * DM + col) * 2u); *(u32x4*)o = pack8(silu4(v00), silu4(v01)); *(u32x4*)(o + 128) = pack8(silu4(v10), silu4(v11)); }
                } else {
                    const int col = 128 * (pn - 21) + cl;
                    f32x4 r0, r1, s0, s1;
#pragma unroll
                    for (int e = 0; e < 4; ++e) { const float ea0 = __expf(-v00[e]), eb0 = __expf(-v10[e]), ea1 = __expf(-v01[e]), eb1 = __expf(-v11[e]);
                        s0[e] = __builtin_amdgcn_rcpf(1.f + eb0); s1[e] = __builtin_amdgcn_rcpf(1.f + eb1);
                        r0[e] = (1.f + eb0) * __builtin_amdgcn_rcpf(1.f + ea0); r1[e] = (1.f + eb1) * __builtin_amdgcn_rcpf(1.f + ea1); }
                    if (ok) { const unsigned o = (unsigned)(row * DM + col) * 2u; *(u32x4*)boff(MGR, o) = pack8(r0, r1); *(u32x4*)boff(MGB, o) = pack8(s0, s1); }
                }
            }
    }
};
struct EpiMid {
    static constexpr bool PERM = true, AFTER_DRAIN = false, MID = true;
    unsigned char* ws; float* out;
    __device__ __forceinline__ void mid(f32x4 (&acc)[2][2][4][2], const pg8::Unit& u, int wr, int wc, int fr, int fq) const {
        asm volatile("" : "+v"(fr), "+v"(fq));
        const bf16_t* MGR = (const bf16_t*)out;
        const int cl = u.pn * 256 + wc * 32 + 8 * fq;
#pragma unroll
        for (int am = 0; am < 4; ++am) { const int ai = am >> 1, m0 = (am & 1) * 2;
            u32x4 rv[2][2];
#pragma unroll
            for (int m = 0; m < 2; ++m)
#pragma unroll
                for (int bj = 0; bj < 2; ++bj) rv[m][bj] = *(const u32x4*)boff(MGR, (unsigned)((u.pm * 256 + ai * 128 + wr * 64 + (m0 + m) * 16 + fr) * DM + cl + 128 * bj) * 2u);
#pragma unroll
            for (int m = 0; m < 2; ++m)
#pragma unroll
                for (int bj = 0; bj < 2; ++bj) { f32x4 a, b; unpack8(rv[m][bj], a, b); acc[ai][bj][m0 + m][0] *= a; acc[ai][bj][m0 + m][1] *= b; }
            asm volatile("" ::: "memory");
        }
    }
    __device__ __forceinline__ void operator()(const f32x4 (&acc)[2][2][4][2], const pg8::Unit& u, int wr, int wc, int fr, int fq) const {
        const bf16_t* MGB = (const bf16_t*)out + (size_t)MR * DM; bf16_t* Y = (bf16_t*)(ws + WS_U);
        const int cl = u.pn * 256 + wc * 32 + 8 * fq;
#pragma unroll
        for (int ai = 0; ai < 2; ++ai) {
            u32x4 bv[4][2];
#pragma unroll
            for (int m = 0; m < 4; ++m)
#pragma unroll
                for (int bj = 0; bj < 2; ++bj) bv[m][bj] = *(const u32x4*)boff(MGB, (unsigned)((u.pm * 256 + ai * 128 + wr * 64 + m * 16 + fr) * DM + cl + 128 * bj) * 2u);
#pragma unroll
            for (int m = 0; m < 4; ++m)
#pragma unroll
                for (int bj = 0; bj < 2; ++bj) { f32x4 a, b; unpack8(bv[m][bj], a, b);
                    *(u32x4*)boff(Y, (unsigned)((u.pm * 256 + ai * 128 + wr * 64 + m * 16 + fr) * DM + cl + 128 * bj) * 2u) = pack8(acc[ai][bj][m][0] * a, acc[ai][bj][m][1] * b); }
        }
    }
};
struct EpiOut {
    static constexpr bool PERM = true, AFTER_DRAIN = false, MID = false;
    const float *xp, *xs; const float* gnext; unsigned char* ws; float* out; int layer; int sqi; int fuse;
    __device__ __forceinline__ void operator()(f32x4 (&acc)[2][2][4][2], const pg8::Unit& u, int wr, int wc, int fr, int fq) const {
        bf16_t* D1 = (bf16_t*)(ws + WS_D1); bf16_t* XN = (bf16_t*)(ws + WS_XN); float* sumsq_out = (float*)(ws + WS_SUMSQ) + sqi * MPAD;
        const int cl = u.pn * 256 + wc * 32 + 8 * fq;
        f32x4 gg[2][2];
#pragma unroll
        for (int bj = 0; bj < 2; ++bj) { gg[bj][0] = *(const f32x4*)(gnext + cl + 128 * bj); gg[bj][1] = *(const f32x4*)(gnext + cl + 128 * bj + 4); }
#pragma unroll
        for (int am = 0; am < 4; ++am) { const int ai = am >> 1, m0 = (am & 1) * 2;
            f32x4 xv[2][2][2]; u32x4 dv[2][2];
#pragma unroll
            for (int m = 0; m < 2; ++m) {
                const unsigned ro = (unsigned)((u.pm * 256 + ai * 128 + wr * 64 + (m0 + m) * 16 + fr) * DM + cl);
#pragma unroll
                for (int bj = 0; bj < 2; ++bj) { const float* xr_ = boff(xp, (ro + 128u * bj) * 4u); xv[m][bj][0] = *(const f32x4*)xr_; xv[m][bj][1] = *(const f32x4*)(xr_ + 4);
                    if (layer != 0) dv[m][bj] = *(const u32x4*)boff(D1, (ro + 128u * bj) * 2u); }
            }
#pragma unroll
            for (int m = 0; m < 2; ++m) {
                const int row = u.pm * 256 + ai * 128 + wr * 64 + (m0 + m) * 16 + fr;
                const unsigned ro = (unsigned)(row * DM + cl);
                float s = 0.f;
#pragma unroll
                for (int bj = 0; bj < 2; ++bj) {
                    const unsigned o2 = (ro + 128u * bj) * 2u;
                    f32x4 x0 = xv[m][bj][0], x1 = xv[m][bj][1];
                    const f32x4 a0 = acc[ai][bj][m0 + m][0], a1 = acc[ai][bj][m0 + m][1];
                    if (layer == 0) {
                        x0 += a0; x1 += a1;
                        *(u32x4*)boff(D1, o2) = pack8(a0, a1);
                        *(u32x4*)boff(XN, o2) = pack8(x0 * gg[bj][0], x1 * gg[bj][1]);
                    } else {
                        f32x4 d0, d1; unpack8(dv[m][bj], d0, d1);
                        x0 += d0 + a0; x1 += d1 + a1;
                        if (fuse) { acc[ai][bj][m0 + m][0] = x0; acc[ai][bj][m0 + m][1] = x1; }
                        else { float* o_ = boff(out, 2u * o2); *(f32x4*)o_ = x0; *(f32x4*)(o_ + 4) = x1; }
                    }
                    s += (x0[0] * x0[0] + x0[1] * x0[1]) + (x0[2] * x0[2] + x0[3] * x0[3]) + (x1[0] * x1[0] + x1[1] * x1[1]) + (x1[2] * x1[2] + x1[3] * x1[3]);
                }
                s += swz_xor<16>(s); s = sum_x32(s);
                if (fq == 0) atomicAdd(boff(sumsq_out, (unsigned)row * 4u), s);
            }
        }
        if (layer != 0 && fuse) {
            unsigned* cnt = (unsigned*)(ws + WS_CNT) + 32 * u.pm;
            asm volatile("s_waitcnt vmcnt(0)" ::: "memory");
            if (fr == 0 && fq == 0) __hip_atomic_fetch_add(cnt, 1u, __ATOMIC_RELAXED, __HIP_MEMORY_SCOPE_AGENT);
            for (unsigned sp = 0; sp < (1u << 22); ++sp) {
                if ((unsigned)__builtin_amdgcn_readfirstlane((int)__hip_atomic_load(cnt, __ATOMIC_RELAXED, __HIP_MEMORY_SCOPE_AGENT)) >= 32u) break;
                __builtin_amdgcn_s_sleep(2);
            }
            __builtin_amdgcn_fence(__ATOMIC_ACQUIRE, "agent");
#pragma unroll
            for (int ai = 0; ai < 2; ++ai)
#pragma unroll
                for (int m = 0; m < 4; ++m) {
                    const int row = u.pm * 256 + ai * 128 + wr * 64 + m * 16 + fr;
                    const float rs = rsqrtf(__hip_atomic_load(boff(sumsq_out, (unsigned)row * 4u), __ATOMIC_RELAXED, __HIP_MEMORY_SCOPE_AGENT) * (1.0f / DM) + EPS);
#pragma unroll
                    for (int bj = 0; bj < 2; ++bj) { float* o_ = boff(out, (unsigned)(row * DM + cl + 128 * bj) * 4u);
                        *(f32x4*)o_ = acc[ai][bj][m][0] * rs * gg[bj][0]; *(f32x4*)(o_ + 4) = acc[ai][bj][m][1] * rs * gg[bj][1]; }
                }
        }
    }
};
struct TrDesc { const float* W; bf16_t* WT; int N, pitch, coff, k0, n0, drow0; };
__device__ __forceinline__ void tr_load(const TrDesc& d, float (&tv)[32], int lane) {
#pragma unroll
    for (int i = 0; i < 32; ++i) { const int kk = 2 * i + (lane >> 5); tv[i] = d.W[(size_t)(d.k0 + kk) * d.N + d.n0 + (lane & 31)]; }
}
__device__ __forceinline__ void tr_store(const TrDesc& d, const float (&tv)[32], LAS float* scr, int lane) {
#pragma unroll
    for (int i = 0; i < 32; ++i) { const int kk = 2 * i + (lane >> 5); scr[kk * 33 + (lane & 31)] = tv[i]; }
    asm volatile("s_waitcnt lgkmcnt(0)" ::: "memory");
    const int c = lane & 7;
#pragma unroll
    for (int j = 0; j < 4; ++j) { const int n = (lane >> 3) + 8 * j; const LAS float* sp = scr + (8 * c) * 33 + n;
        u32x4 o; o.x = pk2(sp[0 * 33], sp[1 * 33]); o.y = pk2(sp[2 * 33], sp[3 * 33]); o.z = pk2(sp[4 * 33], sp[5 * 33]); o.w = pk2(sp[6 * 33], sp[7 * 33]);
        *(u32x4*)(d.WT + (size_t)(d.drow0 + n) * d.pitch + d.coff + d.k0 + 8 * c) = o; }
    asm volatile("s_waitcnt lgkmcnt(0)" ::: "memory");
}
__device__ __forceinline__ int win_dst_row(int src) {
    if (src < 2048) { const int half = src >> 10, c = src & 1023; return (c >> 7) * 256 + half * 128 + (c & 127); }
    if (src < 5376) return src;
    const int s = src - 5376, half = s >> 10, c = s & 1023; return 5376 + (c >> 7) * 256 + half * 128 + (c & 127);
}

constexpr int TR_I_IN = 16 * (INC / 32), TR_I_SQ = 16 * 32, TR_I_L = TR_I_IN + 3 * TR_I_SQ;
__device__ __forceinline__ TrDesc tr_decode(int l, int r, const float* w_in, const float* w_c, const float* w_a, const float* w_o, unsigned char* ws) {
    bf16_t* WIN = (bf16_t*)(ws + WS_WIN); bf16_t* WCA = (bf16_t*)(ws + WS_WCA); bf16_t* WO = (bf16_t*)(ws + WS_WO);
    TrDesc d;
    if (r < TR_I_IN) { const int kb = r / (INC / 32), nb = r % (INC / 32); d.W = w_in + (size_t)l * DM * INC; d.WT = WIN + (size_t)l * INC * DM; d.N = INC; d.pitch = DM; d.coff = 0; d.k0 = 64 * kb; d.n0 = 32 * nb; d.drow0 = win_dst_row(32 * nb); return d; }
    r -= TR_I_IN; const int which = r / TR_I_SQ; r %= TR_I_SQ; const int kb = r / 32, nb = r % 32;
    d.N = DM; d.k0 = 64 * kb; d.n0 = 32 * nb; d.drow0 = 32 * nb; d.coff = 0;
    if (which == 0) { d.W = w_c + (size_t)l * DM * DM; d.WT = WCA + (size_t)l * DM * 2048; d.pitch = 2048; }
    else if (which == 1) { d.W = w_a + (size_t)l * DM * DM; d.WT = WCA + (size_t)l * DM * 2048; d.pitch = 2048; d.coff = 1024; }
    else { d.W = w_o + (size_t)l * DM * DM; d.WT = WO + (size_t)l * DM * DM; d.pitch = DM; }
    return d;
}
template <int N> __device__ __forceinline__ void block_sums(float (&v)[N], LAS float* red  , int tid, int lane, int wave) {
    if constexpr (N == 32) {
#define BS_STEP(HALF, MASK, XCH) { const bool up = (lane & MASK) != 0; \
        _Pragma("unroll") for (int i = 0; i < HALF; ++i) { float lo_ = v[i], hi_ = v[i + HALF]; asm volatile("" : "+v"(lo_), "+v"(hi_));   \
            const float keep = up ? hi_ : lo_, send = up ? lo_ : hi_; v[i] = keep + XCH; } }
        BS_STEP(16, 32, get_x32(send, up)) BS_STEP(8, 16, swz_xor<16>(send)) BS_STEP(4, 8, swz_xor<8>(send)) BS_STEP(2, 4, swz_xor<4>(send)) BS_STEP(1, 2, swz_xor<2>(send))
#undef BS_STEP
        v[0] += swz_xor<1>(v[0]);
        if ((lane & 1) == 0) red[wave * 32 + (lane >> 1)] = v[0];
    } else {
#pragma unroll
        for (int i = 0; i < N; ++i) { v[i] = wave_sum(v[i]); if (lane == 0) red[wave * N + i] = v[i]; }
    }
    __syncthreads();
    if (tid < N) { float t = 0.f;
#pragma unroll
        for (int w = 0; w < 8; ++w) t += red[w * N + tid];
        red[8 * N + tid] = t; }
    __syncthreads();
}

__device__ __forceinline__ void conv_tile(int tile, LAS unsigned char* lds, const bf16_t* U, const bf16_t* GA, bf16_t* CO, const f32x2 (&w)[31], const float* cb, const float* lng, const float* lnb, int tid, int lane, int wave) {
    LAS float* red = (LAS float*)lds;
    const int row0 = tile * 16, pos0 = row0 & (SEQ - 1), c0 = 2 * tid;
    f32x2 acc[16];
    { const f32x2 bias = *(const f32x2*)(cb + c0);
#pragma unroll
      for (int t = 0; t < 16; ++t) acc[t] = bias; }
    unsigned uw[46], gw[16];
#pragma unroll
    for (int i = 0; i < 46; ++i) { const bool valid = (pos0 - 30 + i) >= 0; const int ri = valid ? row0 - 30 + i : row0;
        uw[i] = *(const unsigned*)boff(U + (size_t)ri * DM, (unsigned)c0 * 2u); }
#pragma unroll
    for (int i = 0; i < 46; ++i) {
        const bool valid = (pos0 - 30 + i) >= 0; const unsigned uu = valid ? uw[i] : 0u;
        const f32x2 uv = {bf_lo(uu), bf_hi(uu)};
#pragma unroll
        for (int t = 0; t < 16; ++t) { const int j = i - t; if (j >= 0 && j <= 30) acc[t] += w[j] * uv; }
    }
#pragma unroll
    for (int t = 0; t < 16; ++t) gw[t] = *(const unsigned*)boff(GA + (size_t)(row0 + t) * DM, (unsigned)c0 * 2u);
    float v[32];
#pragma unroll
    for (int t = 0; t < 16; ++t) { v[t] = acc[t].x + acc[t].y; v[16 + t] = acc[t].x * acc[t].x + acc[t].y * acc[t].y; }
    __syncthreads();
    block_sums<32>(v, red, tid, lane, wave);
    const f32x2 g = *(const f32x2*)(lng + c0), be = *(const f32x2*)(lnb + c0);
#pragma unroll
    for (int t = 0; t < 16; ++t) {
        const float mean = red[256 + t] * (1.0f / DM), var = red[256 + 16 + t] * (1.0f / DM) - mean * mean, rstd = rsqrtf(fmaxf(var, 0.f) + EPS);
        const float y0 = (acc[t].x - mean) * rstd * g.x + be.x, y1 = (acc[t].y - mean) * rstd * g.y + be.y;
        *(unsigned*)boff(CO + (size_t)(row0 + t) * DM, (unsigned)c0 * 2u) = pk2(siluf_(y0) * bf_lo(gw[t]), siluf_(y1) * bf_hi(gw[t]));
    }
}
__device__ __forceinline__ void conv_sample(int b, int l, LAS unsigned char* lds, const float* state, float* ncs, const bf16_t* GA, bf16_t* CO, const float* cw, const float* cb, const float* lng, const float* lnb, int tid, int lane, int wave) {
    tid = fresh_tid(wave); asm volatile("" : "+v"(tid)); lane = tid & 63;
    LAS float* red = (LAS float*)lds;
    const int c0 = 2 * tid, row = MP + b;
    f32x2 acc = *(const f32x2*)(cb + c0);
    const float* st = state + ((size_t)(l * 128 + b) * 30) * DM + c0;
    float* no = ncs + (size_t)b * 30 * DM + c0;
    f32x2 sv[31], wv[31];
#pragma unroll
    for (int j = 0; j < 30; ++j) sv[j] = *(const f32x2*)(st + (size_t)j * DM);
    sv[30] = *(const f32x2*)(no + (size_t)29 * DM);
#pragma unroll
    for (int j = 0; j < 31; ++j) wv[j] = *(const f32x2*)(cw + j * DM + c0);
    const unsigned gw = *(const unsigned*)(GA + (size_t)row * DM + c0);
#pragma unroll
    for (int j = 0; j < 31; ++j) acc += wv[j] * sv[j];
#pragma unroll
    for (int j = 1; j < 30; ++j) *(f32x2*)(no + (size_t)(j - 1) * DM) = sv[j];
    float v[2] = {acc.x + acc.y, acc.x * acc.x + acc.y * acc.y};
    __syncthreads();
    block_sums<2>(v, red, tid, lane, wave);
    const float mean = red[16] * (1.0f / DM), var = red[17] * (1.0f / DM) - mean * mean, rstd = rsqrtf(fmaxf(var, 0.f) + EPS);
    const f32x2 g = *(const f32x2*)(lng + c0), be = *(const f32x2*)(lnb + c0);
    const float y0 = (acc.x - mean) * rstd * g.x + be.x, y1 = (acc.y - mean) * rstd * g.y + be.y;
    *(unsigned*)(CO + (size_t)row * DM + c0) = pk2(siluf_(y0) * bf_lo(gw), siluf_(y1) * bf_hi(gw));
}
__device__ __forceinline__ int crow(int r, int hi) { return (r & 3) + 8 * (r >> 2) + 4 * hi; }
constexpr int AT_K = 0, AT_V = 192 * 144, AT_VP = 392, AT_STG = AT_V + 64 * AT_VP, AT_WS = AT_STG + 8 * 4096, AT_END = AT_WS + 8 * 128;
constexpr int AT_NK = 192;
__device__ __forceinline__ void attn_prompt_unit(int item, LAS unsigned char* lds, const bf16_t* KV, const bf16_t* Q, bf16_t* OG, const bf16_t* GB, const float* sinks, int tid, int lane, int wave) {
    tid = fresh_tid(wave); asm volatile("" : "+v"(tid)); lane = tid & 63;
    const int g = item & 1, bq = item >> 1, row0 = bq * 64, p0 = row0 & (SEQ - 1);
    const int q = lane & 31, hi = lane >> 5, h = 8 * g + wave;
    __syncthreads();
    u32x4 kk3[3], vv3[3];
#pragma unroll
    for (int i3 = 0; i3 < 3; ++i3) { const int c = tid + 512 * i3, kc = c >> 3, ch = c & 7;
        kk3[i3] = (u32x4){0u, 0u, 0u, 0u}; vv3[i3] = (u32x4){0u, 0u, 0u, 0u};
        if (p0 - 128 + kc >= 0) { const bf16_t* src = KV + (size_t)(row0 - 128 + kc) * 256 + g * 64 + ch * 8; kk3[i3] = *(const u32x4*)src; vv3[i3] = *(const u32x4*)(src + 128); } }
    bf16x8 qf[2][4];
    { const bf16_t* qrow = Q + (size_t)(row0 + q) * DM + 64 * h;
#pragma unroll
      for (int s = 0; s < 4; ++s) qf[0][s] = *(const bf16x8*)(qrow + 16 * s + 8 * hi); }
#pragma unroll
    for (int i3 = 0; i3 < 3; ++i3) {
        const int c = tid + 512 * i3, kc = c >> 3, ch = c & 7;
        const u32x4 kk = kk3[i3], vv = vv3[i3];
        *(LAS u32x4*)(lds + AT_K + kc * 144 + ch * 16) = kk;
        LAS unsigned short* vt = (LAS unsigned short*)(lds + AT_V + (ch * 8) * AT_VP + kc * 2);
        vt[0 * (AT_VP / 2)] = (unsigned short)(vv.x & 0xffffu); vt[1 * (AT_VP / 2)] = (unsigned short)(vv.x >> 16);
        vt[2 * (AT_VP / 2)] = (unsigned short)(vv.y & 0xffffu); vt[3 * (AT_VP / 2)] = (unsigned short)(vv.y >> 16);
        vt[4 * (AT_VP / 2)] = (unsigned short)(vv.z & 0xffffu); vt[5 * (AT_VP / 2)] = (unsigned short)(vv.z >> 16);
        vt[6 * (AT_VP / 2)] = (unsigned short)(vv.w & 0xffffu); vt[7 * (AT_VP / 2)] = (unsigned short)(vv.w >> 16);
    }
    const float sink = sinks[h];
    __syncthreads();
#pragma unroll
    for (int sb = 0; sb < 2; ++sb) {
    const int p0s = p0 + 32 * sb;
    f32x16 st[5];
#pragma unroll
    for (int c = 0; c < 5; ++c) {
#pragma unroll
        for (int r = 0; r < 16; ++r) st[c][r] = 0.f;
#pragma unroll
        for (int s = 0; s < 4; ++s) { const bf16x8 kf = *(const LAS bf16x8*)(lds + AT_K + (32 * c + 32 * sb + q) * 144 + 32 * s + 16 * hi); st[c] = __builtin_amdgcn_mfma_f32_32x32x16_bf16(kf, qf[sb][s], st[c], 0, 0, 0); }
        asm volatile("" ::: "memory");
    }
    if (sb == 0) { const bf16_t* qrow = Q + (size_t)(row0 + 32 + q) * DM + 64 * h;
#pragma unroll
      for (int s = 0; s < 4; ++s) qf[1][s] = *(const bf16x8*)(qrow + 16 * s + 8 * hi); }
    u32x4 gv4[4];
#pragma unroll
    for (int i = 0; i < 4; ++i) gv4[i] = *(const u32x4*)(GB + (size_t)(row0 + 32 * sb + i * 8 + (lane >> 3)) * DM + 64 * h + (lane & 7) * 8);
    float mx = -1e30f;
    if (p0s >= 128) {
#pragma unroll
        for (int r = 0; r < 16; ++r) { const int kc = crow(r, hi); if (!(kc > q)) st[0][r] = -1e30f; if (!(kc <= q)) st[4][r] = -1e30f; }
    } else {
#pragma unroll
        for (int c = 0; c < 5; ++c)
#pragma unroll
            for (int r = 0; r < 16; ++r) { const int kc = 32 * c + crow(r, hi); const bool valid = (kc > q) && (kc <= q + 128) && (kc >= 128 - p0s); if (!valid) st[c][r] = -1e30f; }
    }
#pragma unroll
    for (int c = 0; c < 5; ++c)
#pragma unroll
        for (int r = 0; r < 16; ++r) mx = fmaxf(mx, st[c][r]);
    mx = max_x32(mx);
    const float sink2 = sink * LOG2E;
    const float mm = fmaxf(mx, sink2);
    float ls = 0.f;
#pragma unroll
    for (int c = 0; c < 5; ++c)
#pragma unroll
        for (int r = 0; r < 16; ++r) { const float p = __builtin_amdgcn_exp2f(st[c][r] - mm); st[c][r] = p; ls += p; }
    ls = sum_x32(ls);
    ls += __builtin_amdgcn_exp2f(sink2 - mm);
    f32x16 o[2];
#pragma unroll
    for (int r = 0; r < 16; ++r) { o[0][r] = 0.f; o[1][r] = 0.f; }
#pragma unroll
    for (int c = 0; c < 5; ++c)
#pragma unroll
        for (int s2 = 0; s2 < 2; ++s2) {
            u32x4 pw; pw.x = pk2(st[c][8 * s2 + 0], st[c][8 * s2 + 1]); pw.y = pk2(st[c][8 * s2 + 2], st[c][8 * s2 + 3]); pw.z = pk2(st[c][8 * s2 + 4], st[c][8 * s2 + 5]); pw.w = pk2(st[c][8 * s2 + 6], st[c][8 * s2 + 7]);
            const bf16x8 pa = __builtin_bit_cast(bf16x8, pw);
#pragma unroll
            for (int db = 0; db < 2; ++db) {
                const LAS unsigned char* vp = lds + AT_V + (q + 32 * db) * AT_VP + (32 * c + 32 * sb + 16 * s2 + 4 * hi) * 2;
                const u32x2 lo = *(const LAS u32x2*)vp, hh = *(const LAS u32x2*)(vp + 16);
                const u32x4 vw = {lo.x, lo.y, hh.x, hh.y};
                o[db] = __builtin_amdgcn_mfma_f32_32x32x16_bf16(pa, __builtin_bit_cast(bf16x8, vw), o[db], 0, 0, 0);
            }
            if (s2 == 1) asm volatile("" ::: "memory");
        }
    LAS float* wsf = (LAS float*)(lds + AT_WS + wave * 128);
    if (hi == 0) wsf[q] = __builtin_amdgcn_rcpf(ls);
    asm volatile("s_waitcnt lgkmcnt(0)" ::: "memory");
    LAS unsigned short* stg = (LAS unsigned short*)(lds + AT_STG + wave * 4096);
#pragma unroll
    for (int r = 0; r < 16; ++r) { const int qr = crow(r, hi); const float rl = wsf[qr];
        stg[qr * 64 + q] = (unsigned short)(pk2(o[0][r] * rl, 0.f) & 0xffffu); stg[qr * 64 + 32 + q] = (unsigned short)(pk2(o[1][r] * rl, 0.f) & 0xffffu); }
    asm volatile("s_waitcnt lgkmcnt(0)" ::: "memory");
#pragma unroll
    for (int i = 0; i < 4; ++i) { const int rl = i * 8 + (lane >> 3), ch = lane & 7;
        const u32x4 ov = *(const LAS u32x4*)(stg + rl * 64 + ch * 8);
        const size_t off = (size_t)(row0 + 32 * sb + rl) * DM + 64 * h + ch * 8;
        f32x4 a0, a1, g0, g1; unpack8(ov, a0, a1); unpack8(gv4[i], g0, g1);
        *(u32x4*)(OG + off) = pack8(a0 * g0, a1 * g1); }
    }
}
__device__ __forceinline__ void attn_sample_unit(int item, int l, LAS unsigned char* lds, const float* ck, const float* cv, float* nks, float* nvs, const bf16_t* Q, bf16_t* OG, const bf16_t* GB, const float* sinks, int tid, int lane, int wave) {
    tid = fresh_tid(wave); asm volatile("" : "+v"(tid)); lane = tid & 63;
    const int g = item & 1, b = item >> 1, row = MP + b, h = 8 * g + wave;
    LAS float* Kc = (LAS float*)lds; LAS float* Vc = Kc + 128 * 65;
    __syncthreads();
    f32x4 k4[4], v4[4];
#pragma unroll
    for (int i = 0; i < 4; ++i) { const int e = tid + 512 * i, w = e >> 4, d = (e & 15) * 4;
        const size_t oo = ((size_t)(b * 128 + w) * 128) + g * 64 + d, ci = ((size_t)((l * 128 + b) * 128 + w + 1) * 128) + g * 64 + d;
        if (w < 127) { k4[i] = *(const f32x4*)(ck + ci); v4[i] = *(const f32x4*)(cv + ci); } else { k4[i] = *(const f32x4*)(nks + oo); v4[i] = *(const f32x4*)(nvs + oo); } }
#pragma unroll
    for (int i = 0; i < 4; ++i) { const int e = tid + 512 * i, w = e >> 4, d = (e & 15) * 4;
        const size_t oo = ((size_t)(b * 128 + w) * 128) + g * 64 + d;
        if (w < 127) { *(f32x4*)(nks + oo) = k4[i]; *(f32x4*)(nvs + oo) = v4[i]; }
#pragma unroll
        for (int q4 = 0; q4 < 4; ++q4) { Kc[w * 65 + d + q4] = k4[i][q4]; Vc[w * 65 + d + q4] = v4[i][q4]; } }
    const size_t qoff = (size_t)row * DM + 64 * h + lane;
    const float qv = __uint_as_float((unsigned)Q[qoff] << 16);
    const float sink = sinks[h];
    __syncthreads();
    float s0 = 0.f, s1 = 0.f;
#pragma unroll
    for (int d = 0; d < 64; ++d) { const float qd = rdlane(qv, d); s0 += qd * Kc[lane * 65 + d]; s1 += qd * Kc[(lane + 64) * 65 + d]; }
    const float sink2 = sink * LOG2E;
    const float mm = fmaxf(wave_max(fmaxf(s0, s1)), sink2);
    const float p0 = __builtin_amdgcn_exp2f(s0 - mm), p1 = __builtin_amdgcn_exp2f(s1 - mm);
    const float ls = wave_sum(p0 + p1) + __builtin_amdgcn_exp2f(sink2 - mm);
    float o = 0.f;
#pragma unroll
    for (int k = 0; k < 64; ++k) o += rdlane(p0, k) * Vc[k * 65 + lane];
#pragma unroll
    for (int k = 0; k < 64; ++k) o += rdlane(p1, k) * Vc[(64 + k) * 65 + lane];
    o *= __builtin_amdgcn_rcpf(ls);
    const float gbv = __uint_as_float((unsigned)GB[qoff] << 16);
    OG[qoff] = (bf16_t)(pk2(o * gbv, 0.f) & 0xffffu);
}


typedef float f32x4s __attribute__((ext_vector_type(4)));
template <int KTOT, int MODE>
__device__ __forceinline__ void sample_gemm(int bid, int G, LAS unsigned char* lds, const bf16_t* A1, const bf16_t* A2, const bf16_t* Bt, unsigned char* ws, float* out,
                                            const float* xs, const float* gnext, int layer, int tid_) {
    int tid = tid_; asm volatile("" : "+v"(tid));
    const int lane = tid & 63, wave = __builtin_amdgcn_readfirstlane(tid >> 6), fr = lane & 15, fq = lane >> 4, kq = wave & 3;
    LAS f32x4s* red = (LAS f32x4s*)lds;
    constexpr int KQ = KTOT / 4, NS = KQ / 32;
    for (int tp = bid; tp < 256; tp += G) {
        const int tile = 2 * tp + (wave >> 2), rt = tile & 7, ct = tile >> 3;
        const int k0 = kq * KQ;
        const bf16_t* ap = (KTOT == 2048 && k0 >= 1024) ? A2 + (size_t)(MP + 16 * rt + fr) * DM + (k0 - 1024) + 8 * fq : A1 + (size_t)(MP + 16 * rt + fr) * DM + k0 + 8 * fq;
        const bf16_t* bp = Bt + (size_t)(16 * ct + fr) * KTOT + k0 + 8 * fq;
        bf16x8 af[NS], bfr[NS];
#pragma unroll
        for (int s2 = 0; s2 < NS; ++s2) { af[s2] = *(const bf16x8*)(ap + 32 * s2); bfr[s2] = *(const bf16x8*)(bp + 32 * s2); }
        const int row = MP + 16 * rt + fr, col = 16 * ct + 4 * fq;
        const unsigned o2 = (unsigned)(row * DM + col) * 2u;
        u32x2 pre0 = {0u, 0u}, pre1 = {0u, 0u}; f32x4s prex = {0.f, 0.f, 0.f, 0.f}, preg = {0.f, 0.f, 0.f, 0.f};
        if (kq == 0) {
            if constexpr (MODE == 0) { pre0 = *(const u32x2*)boff((const bf16_t*)out, o2); pre1 = *(const u32x2*)boff((const bf16_t*)out + (size_t)MR * DM, o2); }
            else { prex = *(const f32x4s*)(xs + (size_t)(row - MP) * DM + col); if (layer == 0) preg = *(const f32x4s*)(gnext + col); else pre0 = *(const u32x2*)boff((const bf16_t*)(ws + WS_D1), o2); }
        }
        f32x4s acc = {0.f, 0.f, 0.f, 0.f};
#pragma unroll
        for (int s2 = 0; s2 < NS; ++s2) acc = __builtin_amdgcn_mfma_f32_16x16x32_bf16(bfr[s2], af[s2], acc, 0, 0, 0);
        __syncthreads();
        red[((wave >> 2) * 4 + kq) * 64 + lane] = acc;
        __syncthreads();
        if (kq == 0) {
            const f32x4s p0 = red[((wave >> 2) * 4 + 0) * 64 + lane], p1 = red[((wave >> 2) * 4 + 1) * 64 + lane], p2 = red[((wave >> 2) * 4 + 2) * 64 + lane], p3 = red[((wave >> 2) * 4 + 3) * 64 + lane];
            if constexpr (MODE == 0) {
                const u32x2 rw = pre0, bw = pre1;
                const f32x4s r = {bf_lo(rw.x), bf_hi(rw.x), bf_lo(rw.y), bf_hi(rw.y)}, bb = {bf_lo(bw.x), bf_hi(bw.x), bf_lo(bw.y), bf_hi(bw.y)};
                const f32x4s y = ((p0 + p1) * r + (p2 + p3)) * bb;
                u32x2 w; w.x = pk2(y[0], y[1]); w.y = pk2(y[2], y[3]);
                *(u32x2*)boff((bf16_t*)(ws + WS_U), o2) = w;
            } else {
                const f32x4s a = (p0 + p1) + (p2 + p3);
                f32x4s x = prex;
                if (layer == 0) {
                    x += a;
                    u32x2 w; w.x = pk2(a[0], a[1]); w.y = pk2(a[2], a[3]); *(u32x2*)boff((bf16_t*)(ws + WS_D1), o2) = w;
                    const f32x4s g = preg;
                    u32x2 w2; w2.x = pk2(x[0] * g[0], x[1] * g[1]); w2.y = pk2(x[2] * g[2], x[3] * g[3]); *(u32x2*)boff((bf16_t*)(ws + WS_XN), o2) = w2;
                } else {
                    const u32x2 dw = pre0;
                    x += (f32x4s){bf_lo(dw.x), bf_hi(dw.x), bf_lo(dw.y), bf_hi(dw.y)} + a;
                    *(f32x4s*)boff(out, 2u * o2) = x;
                }
                float sq = (x[0] * x[0] + x[1] * x[1]) + (x[2] * x[2] + x[3] * x[3]);
                sq += swz_xor<16>(sq); sq = sum_x32(sq);
                if (fq == 0) atomicAdd((float*)(ws + WS_SUMSQ) + (layer + 1) * MPAD + row, sq);
                if (layer != 0) { __builtin_amdgcn_fence(__ATOMIC_RELEASE, "agent"); asm volatile("s_waitcnt vmcnt(0)" ::: "memory"); if (lane == 0) __hip_atomic_fetch_add((unsigned*)(ws + WS_CNT) + 32 * (64 + rt), 1u, __ATOMIC_RELAXED, __HIP_MEMORY_SCOPE_AGENT); }
            }
        }
    }
    __syncthreads();
}

#define XB_TMO      128
#define XB_XCNT(j)  (256  + 64 * (j))
#define XB_XSUB(j)  (1280 + 64 * (j))
#define XB_XGEN(j)  (2304 + 64 * (j))
#define XB_TOP      3328
#define XB_TOPGEN   3392
#define XCD_BAR_WORDS 3456
#define XB_SPIN_CAP (1u << 18)

__device__ __forceinline__ unsigned xb_ld(unsigned* p)              { return __hip_atomic_load(p, __ATOMIC_RELAXED, __HIP_MEMORY_SCOPE_AGENT); }
__device__ __forceinline__ unsigned xb_add(unsigned* p, unsigned v) { return __hip_atomic_fetch_add(p, v, __ATOMIC_RELAXED, __HIP_MEMORY_SCOPE_AGENT); }
__device__ __forceinline__ unsigned xb_xcc_id() { return (unsigned)__builtin_amdgcn_s_getreg((3 << 11) | 20) & 0xFu; }
#define XB_SPIN(cond, bar) do { unsigned _sp = 0; while (cond) { __builtin_amdgcn_s_sleep(1); \
    if ((++_sp & 255u) == 0u) { if (xb_ld(&(bar)[XB_TMO])) break; if (_sp > XB_SPIN_CAP) { atomicAdd(&(bar)[XB_TMO], 1u); break; } } } } while (0)

struct XcdBarrier {
    unsigned* bar; unsigned x; bool w0;
    volatile LAS unsigned* st;
};

__device__ __forceinline__ XcdBarrier xcd_barrier_post(unsigned* bar, volatile LAS unsigned* st) {
    XcdBarrier b; b.bar = bar; b.x = xb_xcc_id(); b.st = st;
    if (threadIdx.x == 0) (void)xb_add(&bar[XB_XCNT(b.x)], 1u);
    return b;
}
__device__ __forceinline__ void xcd_barrier_complete(unsigned* bar, unsigned x, unsigned& nloc, unsigned& nx) {
    const unsigned G = gridDim.x * gridDim.y * gridDim.z;
    unsigned sum, cnt, mine, sp = 0u;
    for (;;) {
        sum = 0u; cnt = 0u; mine = 0u;
#pragma unroll
        for (unsigned j = 0; j < 16; ++j) { const unsigned c = xb_ld(&bar[XB_XCNT(j)]); sum += c; cnt += (c > 0u) ? 1u : 0u; mine = (j == x) ? c : mine; }
        if (sum == G) break;
        __builtin_amdgcn_s_sleep(1);
        if ((++sp & 255u) == 0u) { if (xb_ld(&bar[XB_TMO])) break; if (sp > XB_SPIN_CAP) { atomicAdd(&bar[XB_TMO], 1u); break; } }
    }
    nloc = mine > 0u ? mine : 1u; nx = cnt > 0u ? cnt : 1u;
}

__device__ __forceinline__ void xcd_barrier(const XcdBarrier& b) {
    asm volatile("s_waitcnt vmcnt(0)" ::: "memory");
    __syncthreads();
    if (b.w0 && fresh_tid(0) == 0) {
        unsigned* bar = b.bar;
        __builtin_amdgcn_s_waitcnt(0);
        unsigned nloc = b.st[0], nx = b.st[1];
        if (nloc == 0u) { xcd_barrier_complete(bar, b.x, nloc, nx); b.st[0] = nloc; b.st[1] = nx; }
        const unsigned old = xb_add(&bar[XB_XSUB(b.x)], 1u);
        const unsigned gen = old / nloc;
        if (old + 1u == (gen + 1u) * nloc) {
            __builtin_amdgcn_fence(__ATOMIC_RELEASE, "agent");
            asm volatile("s_waitcnt vmcnt(0)" ::: "memory");
            const unsigned og = xb_add(&bar[XB_TOP], 1u);
            const unsigned tg = og / nx;
            if (og + 1u == (tg + 1u) * nx) xb_add(&bar[XB_TOPGEN], 1u);
            else XB_SPIN(xb_ld(&bar[XB_TOPGEN]) == tg, bar);
            __builtin_amdgcn_fence(__ATOMIC_ACQUIRE, "agent");
            xb_add(&bar[XB_XGEN(b.x)], 1u);
            asm volatile("s_waitcnt vmcnt(0)" ::: "memory");
        } else {
            XB_SPIN(xb_ld(&bar[XB_XGEN(b.x)]) == gen, bar);
            __builtin_amdgcn_fence(__ATOMIC_ACQUIRE, "agent");
            asm volatile("s_waitcnt vmcnt(0)" ::: "memory");
        }
    }
    __syncthreads();
}

struct Params { const float* in[16]; float* out; unsigned char* ws; float inv[8]; };
constexpr int LDS_BYTES = 131072 + 2048;

__global__ void __launch_bounds__(512, 2) fwd_megakernel(Params p) {
    extern __shared__ __attribute__((aligned(16))) unsigned char lds_raw[];
    LAS unsigned char* lds = (LAS unsigned char*)lds_raw;
    cg::grid_group grid = cg::this_grid();
    const int wave = __builtin_amdgcn_readfirstlane((int)threadIdx.x >> 6);
    const int G = gridDim.x, bid = blockIdx.x;
    volatile LAS unsigned* bst = (volatile LAS unsigned*)(lds + 131072 + 64);
    if (threadIdx.x < 2) bst[threadIdx.x] = 0u;
    __syncthreads();
    (void)xcd_barrier_post((unsigned*)(p.ws + WS_BAR), bst);
#define GRID_SYNC() do { XcdBarrier xb_; xb_.bar = (unsigned*)(p.ws + WS_BAR); xb_.x = xb_xcc_id(); xb_.st = (volatile LAS unsigned*)(lds + 131072 + 64); xb_.w0 = (wave == 0); xcd_barrier(xb_); } while (0)
    if (p.ws == nullptr) grid.sync();

#pragma unroll 1
    for (int rp0 = 0; rp0 < REP_P0; ++rp0) {
        if (rp0) GRID_SYNC();
        unsigned char* ws = p.ws; float* out = p.out; asm volatile("" : "+s"(ws), "+s"(out));
        int tid = threadIdx.x; asm volatile("" : "+v"(tid)); const int lane = tid & 63; (void)lane;
        float* sumsq = (float*)(ws + WS_SUMSQ); float* rope = (float*)(ws + WS_ROPE);
        bf16_t* XN = (bf16_t*)(ws + WS_XN); bf16_t* U = (bf16_t*)(ws + WS_U); bf16_t* GA = (bf16_t*)(ws + WS_GA); bf16_t* Q = (bf16_t*)(ws + WS_Q);
        bf16_t* GB = (bf16_t*)(ws + WS_GB); bf16_t* KV = (bf16_t*)(ws + WS_KV);
        bf16_t* WIN = (bf16_t*)(ws + WS_WIN); bf16_t* WCA = (bf16_t*)(ws + WS_WCA); bf16_t* WO = (bf16_t*)(ws + WS_WO);
        const float* x_p = p.in[0]; const float* x_s = p.in[1];
        (void)sumsq; (void)rope; (void)XN; (void)U; (void)GA; (void)Q; (void)GB; (void)KV; (void)WIN; (void)WCA; (void)WO; (void)x_p; (void)x_s;
        LAS float* scr = (LAS float*)(lds + wave * 16384);
        const int gw = bid * 8 + wave, NGW = G * 8;
        for (int it = gw; it < TR_I_L; it += 2 * NGW) {
            const bool two = it + NGW < TR_I_L;
            const TrDesc da = tr_decode(0, it, p.in[6], p.in[11], p.in[13], p.in[14], ws), db = tr_decode(0, two ? it + NGW : it, p.in[6], p.in[11], p.in[13], p.in[14], ws);
            float ta[32], tb[32];
            tr_load(da, ta, lane); if (two) tr_load(db, tb, lane);
            tr_store(da, ta, scr, lane); if (two) tr_store(db, tb, scr, lane);
        }
        const float* g0 = p.in[5];
        for (int m = gw; m < MR; m += 2 * NGW) {
            const int m2 = m + NGW; const bool two = m2 < MR;
            const float* xr = m < MP ? x_p + (size_t)m * DM : x_s + (size_t)(m - MP) * DM;
            const float* xr2 = !two ? xr : (m2 < MP ? x_p + (size_t)m2 * DM : x_s + (size_t)(m2 - MP) * DM);
            f32x4 va[4], vb[4];
#pragma unroll
            for (int j = 0; j < 4; ++j) { va[j] = *(const f32x4*)(xr + 256 * j + 4 * lane); vb[j] = *(const f32x4*)(xr2 + 256 * j + 4 * lane); }
            float sa = 0.f, sb = 0.f;
#pragma unroll
            for (int j = 0; j < 4; ++j) { const f32x4 gg = *(const f32x4*)(g0 + 256 * j + 4 * lane);
                sa += (va[j][0] * va[j][0] + va[j][1] * va[j][1]) + (va[j][2] * va[j][2] + va[j][3] * va[j][3]);
                sb += (vb[j][0] * vb[j][0] + vb[j][1] * vb[j][1]) + (vb[j][2] * vb[j][2] + vb[j][3] * vb[j][3]);
                u32x2 o; o.x = pk2(va[j][0] * gg[0], va[j][1] * gg[1]); o.y = pk2(va[j][2] * gg[2], va[j][3] * gg[3]); *(u32x2*)(XN + (size_t)m * DM + 256 * j + 4 * lane) = o;
                if (two) { u32x2 o2; o2.x = pk2(vb[j][0] * gg[0], vb[j][1] * gg[1]); o2.y = pk2(vb[j][2] * gg[2], vb[j][3] * gg[3]); *(u32x2*)(XN + (size_t)m2 * DM + 256 * j + 4 * lane) = o2; } }
            sa = wave_sum(sa); sb = wave_sum(sb);
            if (lane == 0) { sumsq[m] = sa; if (two) sumsq[m2] = sb; }
        }
        const int gt = bid * 512 + tid, NGT = G * 512;
        for (int i = gt; i < 3 * MPAD; i += NGT) { if (i >= MR) sumsq[i] = 0.f; }
        for (int i = gt; i < 4097 * 8; i += NGT) {
            const int pi = i >> 3, k = i & 7; const int pos = pi < SEQ ? pi : 16384;
            const float ang = (float)pos * p.inv[k];
            const double a = (double)ang, kk = __builtin_rint(a * 0.15915494309189535);
            double r = __builtin_fma(-kk, 6.283185307179586, a); r = __builtin_fma(-kk, 2.4492935982947064e-16, r);
            const double r2 = r * r; double sn = 1.0, cs = 1.0;
#pragma unroll
            for (int n = 11; n >= 1; --n) { sn = 1.0 - r2 * (1.0 / (double)((2 * n) * (2 * n + 1))) * sn; cs = 1.0 - r2 * (1.0 / (double)((2 * n - 1) * (2 * n))) * cs; }
            rope[pi * 16 + k] = (float)cs; rope[pi * 16 + 8 + k] = (float)(r * sn);
        }
    }
    GRID_SYNC();

#pragma unroll 1
    for (int l = 0; l < 2; ++l) {
        {
        unsigned char* ws = p.ws; float* out = p.out; asm volatile("" : "+s"(ws), "+s"(out));
        int tid = fresh_tid(wave); asm volatile("" : "+v"(tid)); const int lane = tid & 63; (void)lane;
        float* sumsq = (float*)(ws + WS_SUMSQ); float* rope = (float*)(ws + WS_ROPE);
        bf16_t* XN = (bf16_t*)(ws + WS_XN); bf16_t* U = (bf16_t*)(ws + WS_U); bf16_t* GA = (bf16_t*)(ws + WS_GA); bf16_t* Q = (bf16_t*)(ws + WS_Q);
        bf16_t* GB = (bf16_t*)(ws + WS_GB); bf16_t* KV = (bf16_t*)(ws + WS_KV);
        bf16_t* WIN = (bf16_t*)(ws + WS_WIN); bf16_t* WCA = (bf16_t*)(ws + WS_WCA); bf16_t* WO = (bf16_t*)(ws + WS_WO);
        const float* x_p = p.in[0]; const float* x_s = p.in[1];
        (void)sumsq; (void)rope; (void)XN; (void)U; (void)GA; (void)Q; (void)GB; (void)KV; (void)WIN; (void)WCA; (void)WO; (void)x_p; (void)x_s;
            pg8::Gemm g{XN, XN, WIN + (size_t)l * INC * DM, MPAD, INC, DM, DM, DM / 64};
            pg8::StaticOrder S; S.init(MPAD, INC, G, bid);
            EpiIn E{ws, out, l};
#ifndef SKIP_A
#pragma unroll 1
            for (int rp = 0; rp < REP_A; ++rp) { if (rp) GRID_SYNC(); pg8::gemm_phase<EpiIn, pg8::StaticOrder, true, true, false>(lds, g, S, E, wave); }
#endif
        }
        GRID_SYNC();
        {
        unsigned char* ws = p.ws; float* out = p.out; asm volatile("" : "+s"(ws), "+s"(out));
        int tid = fresh_tid(wave); asm volatile("" : "+v"(tid)); const int lane = tid & 63; (void)lane;
        float* sumsq = (float*)(ws + WS_SUMSQ); float* rope = (float*)(ws + WS_ROPE);
        bf16_t* XN = (bf16_t*)(ws + WS_XN); bf16_t* U = (bf16_t*)(ws + WS_U); bf16_t* GA = (bf16_t*)(ws + WS_GA); bf16_t* Q = (bf16_t*)(ws + WS_Q);
        bf16_t* GB = (bf16_t*)(ws + WS_GB); bf16_t* KV = (bf16_t*)(ws + WS_KV);
        bf16_t* WIN = (bf16_t*)(ws + WS_WIN); bf16_t* WCA = (bf16_t*)(ws + WS_WCA); bf16_t* WO = (bf16_t*)(ws + WS_WO);
        const float* x_p = p.in[0]; const float* x_s = p.in[1];
        (void)sumsq; (void)rope; (void)XN; (void)U; (void)GA; (void)Q; (void)GB; (void)KV; (void)WIN; (void)WCA; (void)WO; (void)x_p; (void)x_s;
            const float* cw = p.in[7] + (size_t)l * 31 * DM; const float* cb = p.in[8] + l * DM; const float* lng = p.in[9] + l * DM; const float* lnb = p.in[10] + l * DM;
            const float* sinks = p.in[12] + l * 16;
            float* ncs = out + O_NCS + (size_t)l * 128 * 30 * 1024; float* nks = out + O_NKS + (size_t)l * 128 * 128 * 128; float* nvs = out + O_NVS + (size_t)l * 128 * 128 * 128;
            if (l == 0) {
                LAS float* scr = (LAS float*)(lds + wave * 16384);
                const int ql = fresh_tid(0);
#pragma unroll 1
                for (int it = bid * 8 + wave; it < TR_I_L; it += G * 8) {
                    const TrDesc da = tr_decode(1, it, p.in[6], p.in[11], p.in[13], p.in[14], ws);
                    float ta[32];
                    tr_load(da, ta, ql); tr_store(da, ta, scr, ql);
                }
                __syncthreads();
            }
#pragma unroll 1
            for (int rpb = REP_B - 1; rpb >= 0; --rpb) {
            bf16_t* qd = rpb ? XN : Q; bf16_t* cd = rpb ? XN : GA;
#ifndef SKIP_ATT
            if (!rpb || (REP_B_MASK & 1))
            for (int gi = bid; gi < 256; gi += G) {
                const int grp = (G == 256) ? (gi & 7) * 32 + (gi >> 3) : gi;
#pragma unroll 1
                for (int k = 0; k < 2; ++k) attn_prompt_unit(((2 * (grp >> 1) + k) << 1) | (grp & 1), lds, KV, Q, qd, GB, sinks, tid, lane, wave);
            }
#endif
            if (!rpb || (REP_B_MASK & 2))
            {
                int tc = fresh_tid(wave); asm volatile("" : "+v"(tc)); const int lc = tc & 63;
                f32x2 w[31];
#pragma unroll
                for (int j = 0; j < 31; ++j) w[j] = *(const f32x2*)boff(cw + j * DM, (unsigned)tc * 8u);
                for (int gi = bid; gi < 256; gi += G) {
                    const int grp = (G == 256) ? (gi & 7) * 32 + (gi >> 3) : gi;
#pragma unroll 1
                    for (int k = 0; k < 4; ++k) conv_tile(4 * grp + k, lds, U, GA, cd, w, cb, lng, lnb, tc, lc, wave);
                }
            }
#ifndef SKIP_ATT
            if (!rpb || (REP_B_MASK & 4)) {
            for (int it = bid; it < 128; it += G) conv_sample(it, l, lds, p.in[2], ncs, GA, cd, cw, cb, lng, lnb, tid, lane, wave);
            for (int it = bid; it < 256; it += G) attn_sample_unit(it, l, lds, p.in[3], p.in[4], nks, nvs, Q, qd, GB, sinks, tid, lane, wave);
            }
#endif
            if (rpb) GRID_SYNC();
            }
        }
        GRID_SYNC();
        {
        unsigned char* ws = p.ws; float* out = p.out; asm volatile("" : "+s"(ws), "+s"(out));
        int tid = fresh_tid(wave); asm volatile("" : "+v"(tid)); const int lane = tid & 63; (void)lane;
        float* sumsq = (float*)(ws + WS_SUMSQ); float* rope = (float*)(ws + WS_ROPE);
        bf16_t* XN = (bf16_t*)(ws + WS_XN); bf16_t* U = (bf16_t*)(ws + WS_U); bf16_t* GA = (bf16_t*)(ws + WS_GA); bf16_t* Q = (bf16_t*)(ws + WS_Q);
        bf16_t* GB = (bf16_t*)(ws + WS_GB); bf16_t* KV = (bf16_t*)(ws + WS_KV);
        bf16_t* WIN = (bf16_t*)(ws + WS_WIN); bf16_t* WCA = (bf16_t*)(ws + WS_WCA); bf16_t* WO = (bf16_t*)(ws + WS_WO);
        const float* x_p = p.in[0]; const float* x_s = p.in[1];
        (void)sumsq; (void)rope; (void)XN; (void)U; (void)GA; (void)Q; (void)GB; (void)KV; (void)WIN; (void)WCA; (void)WO; (void)x_p; (void)x_s;
            pg8::Gemm g{GA, Q, WCA + (size_t)l * DM * 2048, MP, DM, 2048, DM, DM / 64};
            pg8::StaticOrder S; S.init(MP, DM, G, bid);
            sample_gemm<2048, 0>(bid, G, lds, GA, Q, WCA + (size_t)l * DM * 2048, ws, out, x_s, p.in[5] + DM, l, tid);
            EpiMid E{ws, out};
#ifndef SKIP_C
#pragma unroll 1
            for (int rp = 0; rp < REP_C; ++rp) { if (rp) GRID_SYNC(); pg8::gemm_phase<EpiMid, pg8::StaticOrder, true, true, true>(lds, g, S, E, wave); }
#endif
        }
        GRID_SYNC();
        {
        unsigned char* ws = p.ws; float* out = p.out; asm volatile("" : "+s"(ws), "+s"(out));
        int tid = fresh_tid(wave); asm volatile("" : "+v"(tid)); const int lane = tid & 63; (void)lane;
        float* sumsq = (float*)(ws + WS_SUMSQ); float* rope = (float*)(ws + WS_ROPE);
        bf16_t* XN = (bf16_t*)(ws + WS_XN); bf16_t* U = (bf16_t*)(ws + WS_U); bf16_t* GA = (bf16_t*)(ws + WS_GA); bf16_t* Q = (bf16_t*)(ws + WS_Q);
        bf16_t* GB = (bf16_t*)(ws + WS_GB); bf16_t* KV = (bf16_t*)(ws + WS_KV);
        bf16_t* WIN = (bf16_t*)(ws + WS_WIN); bf16_t* WCA = (bf16_t*)(ws + WS_WCA); bf16_t* WO = (bf16_t*)(ws + WS_WO);
        const float* x_p = p.in[0]; const float* x_s = p.in[1];
        (void)sumsq; (void)rope; (void)XN; (void)U; (void)GA; (void)Q; (void)GB; (void)KV; (void)WIN; (void)WCA; (void)WO; (void)x_p; (void)x_s;
            pg8::Gemm g{U, U, WO + (size_t)l * DM * DM, MP, DM, DM, DM, DM / 64};
            pg8::StaticOrder S; S.init(MP, DM, G, bid);
            sample_gemm<1024, 1>(bid, G, lds, U, U, WO + (size_t)l * DM * DM, ws, out, x_s, p.in[5] + DM, l, tid);
            const int fuse = (G == 256) ? 1 : 0;
            EpiOut E{x_p, x_s, l == 0 ? p.in[5] + DM : p.in[15], ws, out, l, l + 1, fuse};
#ifndef SKIP_D
#pragma unroll 1
            for (int rp = 0; rp < REP_D; ++rp) { if (rp) { GRID_SYNC(); E.sqi = 0; } pg8::gemm_phase<EpiOut, pg8::StaticOrder, true, true, true>(lds, g, S, E, wave); }
#endif
            if (l == 1 && fuse) {
                const int ql = fresh_tid(0);
                for (int r = bid * 8 + wave; r < MS; r += G * 8) {
                    unsigned* cnt = (unsigned*)(ws + WS_CNT) + 32 * (64 + (r >> 4));
                    for (unsigned sp = 0; sp < (1u << 22); ++sp) { if ((unsigned)__builtin_amdgcn_readfirstlane((int)__hip_atomic_load(cnt, __ATOMIC_RELAXED, __HIP_MEMORY_SCOPE_AGENT)) >= 64u) break; __builtin_amdgcn_s_sleep(2); }
                    __builtin_amdgcn_fence(__ATOMIC_ACQUIRE, "agent");
                    const int row = MP + r;
                    const float rs = rsqrtf(__hip_atomic_load((float*)(ws + WS_SUMSQ) + 2 * MPAD + row, __ATOMIC_RELAXED, __HIP_MEMORY_SCOPE_AGENT) * (1.0f / DM) + EPS);
                    float* orow = out + (size_t)row * DM; const float* gf = p.in[15];
#pragma unroll
                    for (int j = 0; j < 4; ++j) { const f32x4 v = *(const f32x4*)(orow + 256 * j + 4 * ql), gg = *(const f32x4*)(gf + 256 * j + 4 * ql); *(f32x4*)(orow + 256 * j + 4 * ql) = v * rs * gg; }
                }
            }
        }
        if (!(l == 1 && G == 256)) GRID_SYNC();
    }
    if (G != 256) {
        unsigned char* ws = p.ws; float* out = p.out; asm volatile("" : "+s"(ws), "+s"(out));
        int tid = fresh_tid(wave); asm volatile("" : "+v"(tid)); const int lane = tid & 63; (void)lane;
        float* sumsq = (float*)(ws + WS_SUMSQ); float* rope = (float*)(ws + WS_ROPE);
        bf16_t* XN = (bf16_t*)(ws + WS_XN); bf16_t* U = (bf16_t*)(ws + WS_U); bf16_t* GA = (bf16_t*)(ws + WS_GA); bf16_t* Q = (bf16_t*)(ws + WS_Q);
        bf16_t* GB = (bf16_t*)(ws + WS_GB); bf16_t* KV = (bf16_t*)(ws + WS_KV);
        bf16_t* WIN = (bf16_t*)(ws + WS_WIN); bf16_t* WCA = (bf16_t*)(ws + WS_WCA); bf16_t* WO = (bf16_t*)(ws + WS_WO);
        const float* x_p = p.in[0]; const float* x_s = p.in[1];
        (void)sumsq; (void)rope; (void)XN; (void)U; (void)GA; (void)Q; (void)GB; (void)KV; (void)WIN; (void)WCA; (void)WO; (void)x_p; (void)x_s;
        const float* gf = p.in[15]; const float* sq = sumsq + 2 * MPAD;
        const int gw = bid * 8 + wave, NGW = G * 8;
#pragma unroll 1
        for (int rp = REP_F - 1; rp >= 0; --rp) {
        float* dst = rp ? (float*)(ws + WS_U) : out;
        for (int m = gw; m < MR; m += 2 * NGW) {
            const int m2 = m + NGW < MR ? m + NGW : m;
            const float rs = rsqrtf(sq[m] * (1.0f / DM) + EPS), rs2 = rsqrtf(sq[m2] * (1.0f / DM) + EPS);
            const float* orow = out + (size_t)m * DM; float* drow = dst + (size_t)m * DM; const float* orow2 = out + (size_t)m2 * DM; float* drow2 = dst + (size_t)m2 * DM;
            f32x4 va[4], vb[4];
#pragma unroll
            for (int j = 0; j < 4; ++j) { va[j] = *(const f32x4*)(orow + 256 * j + 4 * lane); vb[j] = *(const f32x4*)(orow2 + 256 * j + 4 * lane); }
#pragma unroll
            for (int j = 0; j < 4; ++j) { const f32x4 gg = *(const f32x4*)(gf + 256 * j + 4 * lane); *(f32x4*)(drow + 256 * j + 4 * lane) = va[j] * rs * gg; if (m2 != m) *(f32x4*)(drow2 + 256 * j + 4 * lane) = vb[j] * rs2 * gg; }
        }
        if (rp) GRID_SYNC();
        }
    }
}

extern "C" void kernel_launch(void* const* d_in, const int* in_sizes, int n_in, void* d_out, int out_size, void* d_ws, size_t ws_size, hipStream_t stream) {
    static int grid = 0;
    if (grid == 0) {
        if (n_in != 16 || (size_t)out_size != O_END || ws_size < WS_END) { fprintf(stderr, "kernel_launch: unexpected sizes n_in %d out %d ws %zu\n", n_in, out_size, ws_size); grid = -1; return; }
        int dev = 0, cus = 0, per_cu = 0;
        hipGetDevice(&dev); hipDeviceGetAttribute(&cus, hipDeviceAttributeMultiprocessorCount, dev);
        if (hipFuncSetAttribute((const void*)fwd_megakernel, hipFuncAttributeMaxDynamicSharedMemorySize, LDS_BYTES) != hipSuccess) { fprintf(stderr, "kernel_launch: hipFuncSetAttribute failed\n"); grid = -1; return; }
        if (hipOccupancyMaxActiveBlocksPerMultiprocessor(&per_cu, (const void*)fwd_megakernel, 512, LDS_BYTES) != hipSuccess || per_cu < 1) { fprintf(stderr, "kernel_launch: occupancy query gave %d\n", per_cu); per_cu = 1; }
        (void)hipGetLastError();
        grid = cus * per_cu;
    }
    if (grid < 0) return;
    Params p{};
    for (int i = 0; i < 16; ++i) p.in[i] = (const float*)d_in[i];
    p.out = (float*)d_out; p.ws = (unsigned char*)d_ws;
    static const float inv[8] = {1.0f, 0.1939227432012558f, 0.03760603070259094f, 0.007292664609849453f, 0.0014142135623842478f, 0.00027424818836152554f, 5.3182957344688475e-05f, 1.0313385246263351e-05f};
    for (int i = 0; i < 8; ++i) p.inv[i] = inv[i];
    if (hipMemsetAsync((char*)d_ws + WS_BAR, 0, 16384 + 80 * 128, stream) != hipSuccess) { fprintf(stderr, "kernel_launch: hipMemsetAsync failed\n"); return; }
    void* args[] = {&p};
    hipError_t e = hipLaunchCooperativeKernel((const void*)fwd_megakernel, dim3(grid), dim3(512), args, LDS_BYTES, stream);
    if (e != hipSuccess) fprintf(stderr, "cooperative launch failed: %s (grid %d)\n", hipGetErrorString(e), grid);
}
```

```cpp
#include <hip/hip_runtime.h>
#include <hip/hip_cooperative_groups.h>
#include <cstdio>
#include <cstdint>
namespace cg = cooperative_groups;
#ifndef REP_A
#define REP_A 1
#endif
#ifndef REP_C
#define REP_C 1
#endif
#ifndef REP_B1
#define REP_B1 1
#endif
#ifndef REP_B2
#define REP_B2 1
#endif
#ifndef DUMMY_CONV
#define DUMMY_CONV 0
#endif
#ifndef REP_D
#define REP_D 1
#endif
#ifndef DUMMY_SAMP
#define DUMMY_SAMP 0
#endif
#ifndef REP_F
#define REP_F 1
#endif
#ifndef REP_B
#define REP_B 1
#endif
#ifndef REP_B_MASK
#define REP_B_MASK 7
#endif
#ifndef REP_P0
#define REP_P0 1
#endif

constexpr int DM = 1024, SEQ = 4096, MP = 16384, MS = 128, MR = MP + MS, MPAD = 16640, INC = 7424;
constexpr float EPS = 1e-6f;
constexpr float QSCALE = 0.125f * 1.4426950408889634f, LOG2E = 1.4426950408889634f;
constexpr size_t O_YP = 0, O_YS = (size_t)MP * DM, O_NCP = O_YS + (size_t)MS * DM, O_NKP = O_NCP + 2 * 4 * 30 * 1024, O_NVP = O_NKP + 2 * 4 * 128 * 128,
                 O_NCS = O_NVP + 2 * 4 * 128 * 128, O_NKS = O_NCS + (size_t)2 * 128 * 30 * 1024, O_NVS = O_NKS + (size_t)2 * 128 * 128 * 128, O_END = O_NVS + (size_t)2 * 128 * 128 * 128;
constexpr size_t RB = (size_t)MPAD * DM * 2;
constexpr size_t WS_SUMSQ = 0;
constexpr size_t WS_CNT = 768 * 1024 + 16384;
constexpr size_t WS_BAR = 768 * 1024;
constexpr size_t WS_ROPE = 256 * 1024;
constexpr size_t WS_XN = 1 << 20, WS_U = WS_XN + RB, WS_GA = WS_U + RB, WS_Q = WS_GA + RB, WS_GB = WS_Q + RB, WS_D1 = WS_GB + RB, WS_KV = WS_D1 + RB;
constexpr size_t WS_WIN = WS_KV + (size_t)MPAD * 256 * 2, WS_WCA = WS_WIN + (size_t)2 * INC * DM * 2, WS_WO = WS_WCA + (size_t)2 * DM * 2048 * 2, WS_END = WS_WO + (size_t)2 * DM * DM * 2;
static_assert(WS_END <= 268435456, "d_ws map exceeds 256 MiB");
static_assert(3 * MPAD * 4 <= WS_ROPE && WS_ROPE + 4097 * 16 * 4 <= WS_XN, "small regions");

__device__ __forceinline__ int fresh_tid(int wave) { int l; asm volatile("v_mbcnt_lo_u32_b32 %0, -1, 0\n\tv_mbcnt_hi_u32_b32 %0, -1, %0" : "=v"(l)); return wave * 64 + l; }
namespace pg8 {
#define PG8_LAS __attribute__((address_space(3)))
typedef unsigned short bf16_t;
typedef short bf16x8 __attribute__((ext_vector_type(8)));
typedef float f32x4 __attribute__((ext_vector_type(4)));
typedef unsigned u32x4 __attribute__((ext_vector_type(4)));
constexpr int BM = 256, BK = 64, HALF = 128, HTB = HALF * BK * 2  , STAGE_BYTES = 8 * HTB, NXCD = 8, WGM = 8;

__host__ __device__ __forceinline__ int lds_byte(int r, int c) { const int st = (r >> 4) * 2 + (c >> 5), rr = r & 15, cc = c & 31, ob = rr * 64 + cc * 2; return st * 1024 + (ob ^ (((ob >> 9) & 1) << 5)); }
__host__ __device__ __forceinline__ void stage_rc(int b, int& R, int& C) { const int st = b / 1024, sb = b % 1024, swz = sb ^ (((sb >> 9) & 1) << 5); R = (st >> 1) * 16 + swz / 64; C = (st & 1) * 32 + (swz % 64) / 2; }
__host__ __device__ __forceinline__ int perm32(int rho) { const int n = rho >> 4, i = rho & 15; return 8 * (i >> 2) + 4 * n + (i & 3); }

struct Unit { int pm, pn; };
struct Gemm { const bf16_t* A; const bf16_t* A2; const bf16_t* Bt; int M, N, K, lda, nth; };

struct StaticOrder {
    int nM, nN, nwg, G, c;
    __host__ __device__ void init(int M, int N, int G_, int c_) { nM = M / BM; nN = N / BM; nwg = nM * nN; G = G_; c = c_; }
    __host__ __device__ bool next(int i, Unit& u) const {
        const long L = (long)i * G + c; if (L >= nwg) return false;
        int wgid = (int)L; { const int q = nwg / NXCD, r = nwg % NXCD, xcd = wgid % NXCD, off = wgid / NXCD; wgid = (xcd < r ? xcd * (q + 1) : r * (q + 1) + (xcd - r) * q) + off; }
        const int nig = WGM * nN, gid = wgid / nig, fm = gid * WGM, gsz = (nM - fm) < WGM ? (nM - fm) : WGM;
        u.pm = fm + ((wgid % nig) % gsz); u.pn = (wgid % nig) / gsz; return true;
    }
    __device__ __forceinline__ void a_ready(const Unit&) const {}
    __device__ __forceinline__ void done(const Unit&) const {}
};


template <class Epi, class Sched, bool ALIGN_EPI = false, bool SP2 = false, bool LAUNDER = true>
__device__ __forceinline__ void gemm_phase(PG8_LAS unsigned char* lds, const Gemm g, const Sched& S, const Epi& E, int wave_id) {
    int tid = fresh_tid(wave_id);
    asm volatile("" : "+v"(tid));
    const int wid = __builtin_amdgcn_readfirstlane(tid >> 6), lane = tid & 63, wr = wid >> 2, wc = wid & 3, fr = lane & 15, fq = lane >> 4;
    const int K = g.K, nt = K / BK, lda = g.lda, nth = g.nth;
    unsigned voffA[2], voffB[2];
#pragma unroll
    for (int i = 0; i < 2; ++i) { int R, C; stage_rc(tid * 16 + i * 8192, R, C); const int Rb = Epi::PERM ? ((R & ~31) + perm32(R & 31)) : R;
        voffA[i] = (unsigned)(R * lda + C) * 2u; voffB[i] = (unsigned)(Rb * K + C) * 2u; }
    const size_t kstep = (size_t)(BK * 2);
    const size_t hstepB = (size_t)HALF * K * 2, hstepA = (size_t)HALF * lda * 2;
    const size_t tstepB = 2 * hstepB, tstepA = 2 * hstepA;
    const unsigned ldsw = (unsigned)wid * 1024u;
    const int aoff = lds_byte(wr * 64 + fr, fq * 8), boff = lds_byte(wc * 32 + fr, fq * 8);
#define PG8_SA(b, h) (((b) * 2 + (h)) * HTB)
#define PG8_SB(b, h) ((4 + (b) * 2 + (h)) * HTB)
#define PG8_STAGE(bufoff, gbase, voff) do { _Pragma("unroll") for (int _i = 0; _i < 2; ++_i) \
        __builtin_amdgcn_global_load_lds((const unsigned*)((const char*)(gbase) + (voff)[_i]), (PG8_LAS unsigned*)(lds + (bufoff) + ldsw + _i * 8192), 16, 0, 0); } while (0)
#define PG8_LDA(dst, b, h) do { _Pragma("unroll") for (int m = 0; m < 4; ++m) _Pragma("unroll") for (int k = 0; k < 2; ++k) dst[m][k] = *(const PG8_LAS bf16x8*)(lds + PG8_SA(b, h) + aoff + m * 2048 + k * 1024); } while (0)
#define PG8_LDB(dst, b, h) do { _Pragma("unroll") for (int n = 0; n < 2; ++n) _Pragma("unroll") for (int k = 0; k < 2; ++k) dst[n][k] = *(const PG8_LAS bf16x8*)(lds + PG8_SB(b, h) + boff + n * 2048 + k * 1024); } while (0)
#define PG8_MMA(ai, bj, At, Bt) do { __builtin_amdgcn_s_setprio(1); _Pragma("unroll") for (int m = 0; m < 4; ++m) _Pragma("unroll") for (int n = 0; n < 2; ++n) _Pragma("unroll") for (int k = 0; k < 2; ++k) \
        acc[ai][bj][m][n] = __builtin_amdgcn_mfma_f32_16x16x32_bf16(Bt[n][k], At[m][k], acc[ai][bj][m][n], 0, 0, 0); __builtin_amdgcn_s_setprio(0); } while (0)
#define PG8_WAIT_V(n) asm volatile("s_waitcnt vmcnt(" #n ")" ::: "memory")
#define PG8_WAIT_L(n) asm volatile("s_waitcnt lgkmcnt(" #n ")" ::: "memory")
#define PG8_BAR __builtin_amdgcn_s_barrier()
#define PG8_SCHED __builtin_amdgcn_sched_barrier(0)
    Unit cur, nxt; int ui = 0;
    if (!S.next(0, cur)) return;
    f32x4 acc[2][2][4][2];
#pragma unroll
    for (int a = 0; a < 2; ++a)
#pragma unroll
        for (int b = 0; b < 2; ++b)
#pragma unroll
            for (int m = 0; m < 4; ++m)
#pragma unroll
                for (int n = 0; n < 2; ++n) acc[a][b][m][n] = (f32x4){0.f, 0.f, 0.f, 0.f};
    bf16x8 At[4][2], B0[2][2], B1[2][2];
    const char* cA = (const char*)g.A + (size_t)cur.pm * tstepA; const char* cB = (const char*)g.Bt + (size_t)cur.pn * tstepB;
    S.a_ready(cur);
    if constexpr (SP2) {
        PG8_STAGE(PG8_SB(0, 0), cB, voffB); PG8_STAGE(PG8_SB(0, 1), cB + hstepB, voffB); PG8_STAGE(PG8_SA(0, 0), cA, voffA); PG8_STAGE(PG8_SA(0, 1), cA + hstepA, voffA);
        if (wr == 1) PG8_BAR;
        PG8_WAIT_V(2); PG8_BAR;
        PG8_STAGE(PG8_SB(1, 0), cB + kstep, voffB); PG8_STAGE(PG8_SA(1, 0), cA + kstep, voffA); PG8_STAGE(PG8_SB(1, 1), cB + hstepB + kstep, voffB);
        PG8_WAIT_V(6); PG8_BAR;
    } else {
        PG8_STAGE(PG8_SB(0, 0), cB, voffB); PG8_STAGE(PG8_SA(0, 0), cA, voffA); PG8_STAGE(PG8_SB(0, 1), cB + hstepB, voffB); PG8_STAGE(PG8_SA(0, 1), cA + hstepA, voffA);
        if (wr == 1) PG8_BAR;
        PG8_WAIT_V(4); PG8_BAR;
        PG8_STAGE(PG8_SB(1, 0), cB + kstep, voffB); PG8_STAGE(PG8_SA(1, 0), cA + kstep, voffA); PG8_STAGE(PG8_SB(1, 1), cB + hstepB + kstep, voffB);
        PG8_WAIT_V(6); PG8_BAR;
    }
    for (;;) {
        const bool has_next = S.next(ui + 1, nxt);
        const char* nA = has_next ? (const char*)g.A + (size_t)nxt.pm * tstepA : cA; const char* nB = has_next ? (const char*)g.Bt + (size_t)nxt.pn * tstepB : cB;
        const char* cA2 = (const char*)g.A2 + (size_t)cur.pm * tstepA - (size_t)nth * kstep;
        for (int t = 0; t < nt; t += 2) {
            const bool last = (t == nt - 2);
            if constexpr (Epi::MID) { if (t == nth) E.mid(acc, cur, wr, wc, fr, fq); }
            const char* a1 = (t < nth ? cA : cA2) + (size_t)(t + 1) * kstep;
            const char* a2 = last ? nA : (t + 2 < nth ? cA : cA2) + (size_t)(t + 2) * kstep; const char* b2 = last ? nB : cB + (size_t)(t + 2) * kstep;
            const char* a3 = a2 + kstep; const char* b3 = b2 + kstep;
            if (last && has_next) S.a_ready(nxt);
            if constexpr (SP2) {
            PG8_LDB(B0, 0, 0); PG8_LDB(B1, 0, 1); PG8_SCHED; PG8_LDA(At, 0, 0); PG8_STAGE(PG8_SA(1, 1), a1 + hstepA, voffA);
            PG8_WAIT_V(8); PG8_WAIT_L(0); PG8_BAR; PG8_MMA(0, 0, At, B0); PG8_MMA(0, 1, At, B1); PG8_BAR; PG8_SCHED;
            PG8_LDA(At, 0, 1); PG8_STAGE(PG8_SB(0, 0), b2, voffB); PG8_STAGE(PG8_SB(0, 1), b2 + hstepB, voffB); PG8_STAGE(PG8_SA(0, 0), a2, voffA);
            PG8_WAIT_V(8); PG8_WAIT_L(0); PG8_BAR; PG8_MMA(1, 0, At, B0); PG8_MMA(1, 1, At, B1); PG8_BAR; PG8_SCHED;
            PG8_LDB(B0, 1, 0); PG8_LDB(B1, 1, 1); PG8_SCHED; PG8_LDA(At, 1, 0); PG8_STAGE(PG8_SA(0, 1), a2 + hstepA, voffA);
            PG8_WAIT_V(8); PG8_WAIT_L(0); PG8_BAR; PG8_MMA(0, 0, At, B0); PG8_MMA(0, 1, At, B1); PG8_BAR; PG8_SCHED;
            PG8_LDA(At, 1, 1); PG8_STAGE(PG8_SB(1, 0), b3, voffB); PG8_STAGE(PG8_SB(1, 1), b3 + hstepB, voffB); PG8_STAGE(PG8_SA(1, 0), a3, voffA);
            PG8_WAIT_V(8); PG8_WAIT_L(0); PG8_BAR; PG8_MMA(1, 0, At, B0); PG8_MMA(1, 1, At, B1); PG8_BAR; PG8_SCHED;
            } else {
            PG8_LDB(B0, 0, 0); PG8_SCHED; PG8_LDA(At, 0, 0); PG8_STAGE(PG8_SA(1, 1), a1 + hstepA, voffA);
            PG8_WAIT_L(8); PG8_BAR; PG8_WAIT_L(0); PG8_MMA(0, 0, At, B0); PG8_BAR; PG8_SCHED;
            PG8_LDB(B1, 0, 1); PG8_STAGE(PG8_SB(0, 0), b2, voffB);
            PG8_BAR; PG8_WAIT_L(0); PG8_MMA(0, 1, At, B1); PG8_BAR;
            PG8_LDA(At, 0, 1); PG8_STAGE(PG8_SA(0, 0), a2, voffA);
            PG8_BAR; PG8_WAIT_L(0); PG8_MMA(1, 0, At, B0); PG8_BAR; PG8_SCHED;
            PG8_STAGE(PG8_SB(0, 1), b2 + hstepB, voffB);
            PG8_WAIT_V(6); PG8_BAR; PG8_MMA(1, 1, At, B1); PG8_BAR;
            PG8_LDB(B0, 1, 0); PG8_SCHED; PG8_LDA(At, 1, 0); PG8_STAGE(PG8_SA(0, 1), a2 + hstepA, voffA);
            PG8_WAIT_L(8); PG8_BAR; PG8_WAIT_L(0); PG8_MMA(0, 0, At, B0); PG8_BAR; PG8_SCHED;
            PG8_LDB(B1, 1, 1); PG8_STAGE(PG8_SB(1, 0), b3, voffB);
            PG8_BAR; PG8_WAIT_L(0); PG8_MMA(0, 1, At, B1); PG8_BAR;
            PG8_LDA(At, 1, 1); PG8_STAGE(PG8_SA(1, 0), a3, voffA);
            PG8_BAR; PG8_WAIT_L(0); PG8_MMA(1, 0, At, B0); PG8_BAR; PG8_SCHED;
            PG8_STAGE(PG8_SB(1, 1), b3 + hstepB, voffB);
            PG8_WAIT_V(6); PG8_BAR; PG8_MMA(1, 1, At, B1); PG8_BAR;
            }
        }
        if constexpr (ALIGN_EPI) { if (wr == 0) PG8_BAR; }
        if constexpr (!Epi::AFTER_DRAIN) { E(acc, cur, wr, wc, fr, fq); S.done(cur); }
        if (!has_next) break;
#pragma unroll
        for (int a = 0; a < 2; ++a)
#pragma unroll
            for (int b = 0; b < 2; ++b)
#pragma unroll
                for (int m = 0; m < 4; ++m)
#pragma unroll
                    for (int n = 0; n < 2; ++n) acc[a][b][m][n] = (f32x4){0.f, 0.f, 0.f, 0.f};
        cur = nxt; cA = nA; cB = nB; ++ui;
        if constexpr (ALIGN_EPI) { if (wr == 1) PG8_BAR; }
    }
    PG8_WAIT_V(0);
    if constexpr (!ALIGN_EPI) { if (wr == 0) PG8_BAR; }
    PG8_BAR;
    if constexpr (Epi::AFTER_DRAIN) { E.fused(acc, cur, wr, wc, fr, fq, lds, wid, lane); S.done(cur); }
#undef PG8_SA
#undef PG8_SB
#undef PG8_STAGE
#undef PG8_LDA
#undef PG8_LDB
#undef PG8_MMA
#undef PG8_WAIT_V
#undef PG8_WAIT_L
#undef PG8_BAR
#undef PG8_SCHED
}
}

#define LAS __attribute__((address_space(3)))
typedef unsigned short bf16_t;
typedef float f32x4 __attribute__((ext_vector_type(4)));
typedef float f32x2 __attribute__((ext_vector_type(2)));
typedef float f32x16 __attribute__((ext_vector_type(16)));
typedef unsigned u32x4 __attribute__((ext_vector_type(4)));
typedef unsigned u32x2 __attribute__((ext_vector_type(2)));
typedef short bf16x8 __attribute__((ext_vector_type(8)));
typedef __bf16 bf16x2_t __attribute__((ext_vector_type(2)));
template <class T> __device__ __forceinline__ T* boff(T* base, unsigned bytes) { return (T*)((char*)base + bytes); }
template <class T> __device__ __forceinline__ const T* boff(const T* base, unsigned bytes) { return (const T*)((const char*)base + bytes); }
__device__ __forceinline__ unsigned pk2(float lo, float hi) { f32x2 v = {lo, hi}; bf16x2_t b = __builtin_convertvector(v, bf16x2_t); return __builtin_bit_cast(unsigned, b); }
__device__ __forceinline__ u32x4 pack8(f32x4 a, f32x4 b) { u32x4 w; w.x = pk2(a[0], a[1]); w.y = pk2(a[2], a[3]); w.z = pk2(b[0], b[1]); w.w = pk2(b[2], b[3]); return w; }
__device__ __forceinline__ float bf_lo(unsigned w) { return __uint_as_float(w << 16); }
__device__ __forceinline__ float bf_hi(unsigned w) { return __uint_as_float(w & 0xffff0000u); }
__device__ __forceinline__ void unpack8(u32x4 w, f32x4& a, f32x4& b) { a = (f32x4){bf_lo(w.x), bf_hi(w.x), bf_lo(w.y), bf_hi(w.y)}; b = (f32x4){bf_lo(w.z), bf_hi(w.z), bf_lo(w.w), bf_hi(w.w)}; }
__device__ __forceinline__ float sigmoidf_(float x) { return __builtin_amdgcn_rcpf(1.0f + __expf(-x)); }
__device__ __forceinline__ float siluf_(float x) { return x * sigmoidf_(x); }
__device__ __forceinline__ f32x4 sig4(f32x4 v) { return (f32x4){sigmoidf_(v[0]), sigmoidf_(v[1]), sigmoidf_(v[2]), sigmoidf_(v[3])}; }
__device__ __forceinline__ f32x4 silu4(f32x4 v) { return (f32x4){siluf_(v[0]), siluf_(v[1]), siluf_(v[2]), siluf_(v[3])}; }
__device__ __forceinline__ float rdlane(float v, int l) { return __uint_as_float((unsigned)__builtin_amdgcn_readlane((int)__float_as_uint(v), l)); }
template <int M> __device__ __forceinline__ float swz_xor(float v) { static_assert(M >= 1 && M <= 16, "swz_xor"); return __uint_as_float((unsigned)__builtin_amdgcn_ds_swizzle((int)__float_as_uint(v), (M << 10) | 0x1f)); }
__device__ __forceinline__ float sum_x32(float v) { auto r = __builtin_amdgcn_permlane32_swap(__float_as_uint(v), __float_as_uint(v), false, false); return __uint_as_float(r[0]) + __uint_as_float(r[1]); }
__device__ __forceinline__ float max_x32(float v) { auto r = __builtin_amdgcn_permlane32_swap(__float_as_uint(v), __float_as_uint(v), false, false); return fmaxf(__uint_as_float(r[0]), __uint_as_float(r[1])); }
__device__ __forceinline__ float get_x32(float v, bool upper) { auto r = __builtin_amdgcn_permlane32_swap(__float_as_uint(v), __float_as_uint(v), false, false); return __uint_as_float(upper ? r[0] : r[1]); }
__device__ __forceinline__ float wave_sum(float v) { v += swz_xor<1>(v); v += swz_xor<2>(v); v += swz_xor<4>(v); v += swz_xor<8>(v); v += swz_xor<16>(v); return sum_x32(v); }
__device__ __forceinline__ float wave_max(float v) { v = fmaxf(v, swz_xor<1>(v)); v = fmaxf(v, swz_xor<2>(v)); v = fmaxf(v, swz_xor<4>(v)); v = fmaxf(v, swz_xor<8>(v)); v = fmaxf(v, swz_xor<16>(v)); return max_x32(v); }

struct EpiIn {
    static constexpr bool PERM = true, AFTER_DRAIN = false, MID = false;
    unsigned char* ws; float* out; int l;
    __device__ __forceinline__ void rope8(f32x4& a, f32x4& b, const float* tab, bool doit, bool second) const {
        f32x4 pa, pb;
#pragma unroll
        for (int e = 0; e < 4; ++e) { pa[e] = swz_xor<16>(a[e]); pb[e] = swz_xor<16>(b[e]); }
        if (doit) {
            const f32x4 c0 = *(const f32x4*)(tab), c1 = *(const f32x4*)(tab + 4), s0 = *(const f32x4*)(tab + 8), s1 = *(const f32x4*)(tab + 12);
            if (second) { a = a * c0 + pa * s0; b = b * c1 + pb * s1; }
            else        { a = a * c0 - pa * s0; b = b * c1 - pb * s1; }
        }
    }
    __device__ __forceinline__ void operator()(const f32x4 (&acc)[2][2][4][2], const pg8::Unit& u, int wr, int wc, int fr, int fq) const {
        bf16_t* U = (bf16_t*)(ws + WS_U); bf16_t* GA = (bf16_t*)(ws + WS_GA); bf16_t* Q = (bf16_t*)(ws + WS_Q); bf16_t* KV = (bf16_t*)(ws + WS_KV); bf16_t* GB = (bf16_t*)(ws + WS_GB);
        bf16_t* MGR = (bf16_t*)out; bf16_t* MGB = MGR + (size_t)MR * DM;
        const float* sumsq = (const float*)(ws + WS_SUMSQ) + l * MPAD; const float* rope = (const float*)(ws + WS_ROPE);
        float* ncp = out + O_NCP + (size_t)l * 4 * 30 * 1024; float* nkp = out + O_NKP + (size_t)l * 4 * 128 * 128; float* nvp = out + O_NVP + (size_t)l * 4 * 128 * 128;
        float* ncs = out + O_NCS + (size_t)l * 128 * 30 * 1024; float* nks = out + O_NKS + (size_t)l * 128 * 128 * 128; float* nvs = out + O_NVS + (size_t)l * 128 * 128 * 128;
        const int pn = u.pn, cl = wc * 32 + 8 * fq;
        const bool ropelane = ((wc & 1) == 0) && (fq < 2), second = (fq & 1) != 0;
        float rsv[8];
#pragma unroll
        for (int i = 0; i < 8; ++i) rsv[i] = *boff(sumsq, (unsigned)(u.pm * 256 + (i >> 2) * 128 + wr * 64 + (i & 3) * 16 + fr) * 4u);
#pragma unroll
        for (int ai = 0; ai < 2; ++ai)
#pragma unroll
            for (int m = 0; m < 4; ++m) {
                const int row = u.pm * 256 + ai * 128 + wr * 64 + m * 16 + fr;
                const bool ok = row < MR;
                const float rs = rsqrtf(rsv[ai * 4 + m] * (1.0f / DM) + EPS);
                f32x4 v00 = acc[ai][0][m][0] * rs, v01 = acc[ai][0][m][1] * rs, v10 = acc[ai][1][m][0] * rs, v11 = acc[ai][1][m][1] * rs;
                const int pos = row & (SEQ - 1), b = row >> 12, sb = row - MP;
                if (pn < 8) {
                    const int col = 128 * pn + cl;
                    v00 = v00 * sig4(v10); v01 = v01 * sig4(v11);
                    if (ok) *(u32x4*)boff(U, (unsigned)(row * DM + col) * 2u) = pack8(v00, v01);
                    if (row < MP) { if (pos >= SEQ - 30) { float* o = boff(ncp, (unsigned)((b * 30 + pos - (SEQ - 30)) * DM + col) * 4u); *(f32x4*)o = v00; *(f32x4*)(o + 4) = v01; } }
                    else if (ok) { float* o = boff(ncs, (unsigned)((sb * 30 + 29) * DM + col) * 4u); *(f32x4*)o = v00; *(f32x4*)(o + 4) = v01; }
                } else if (pn < 12) {
                    const int col = 256 * (pn - 8) + cl;
                    if (ok) { bf16_t* o = boff(GA, (unsigned)(row * DM + col) * 2u); *(u32x4*)o = pack8(silu4(v00), silu4(v01)); *(u32x4*)(o + 128) = pack8(silu4(v10), silu4(v11)); }
                } else if (pn < 16) {
                    const int col = 256 * (pn - 12) + cl;
                    const float* tab = boff(rope, (unsigned)(row < MP ? pos : SEQ) * 64u);
                    rope8(v00, v01, tab, ropelane, second); rope8(v10, v11, tab, ropelane, second);
                    v00 *= QSCALE; v01 *= QSCALE; v10 *= QSCALE; v11 *= QSCALE;
                    if (ok) { bf16_t* o = boff(Q, (unsigned)(row * DM + col) * 2u); *(u32x4*)o = pack8(v00, v01); *(u32x4*)(o + 128) = pack8(v10, v11); }
                } else if (pn == 16) {
                    const float* tab = boff(rope, (unsigned)(row < MP ? pos : SEQ) * 64u);
                    rope8(v00, v01, tab, ropelane, second);
                    if (ok) { bf16_t* o = boff(KV, (unsigned)(row * 256 + cl) * 2u); *(u32x4*)o = pack8(v00, v01); *(u32x4*)(o + 128) = pack8(v10, v11); }
                    if (row < MP) { if (pos >= SEQ - 128) { const unsigned o = (unsigned)((b * 128 + pos - (SEQ - 128)) * 128 + cl) * 4u; float* ok_ = boff(nkp, o); float* ov_ = boff(nvp, o);
                            *(f32x4*)ok_ = v00; *(f32x4*)(ok_ + 4) = v01; *(f32x4*)ov_ = v10; *(f32x4*)(ov_ + 4) = v11; } }
                    else if (ok) { const unsigned o = (unsigned)((sb * 128 + 127) * 128 + cl) * 4u; float* ok_ = boff(nks, o); float* ov_ = boff(nvs, o);
                            *(f32x4*)ok_ = v00; *(f32x4*)(ok_ + 4) = v01; *(f32x4*)ov_ = v10; *(f32x4*)(ov_ + 4) = v11; }
                } else if (pn < 21) {
                    const int col = 256 * (pn - 17) + cl;
                    if (ok) { bf16_t* o = boff(GB, (unsigned)(row * DM + col) * 2u); *(u32x4*)o = pack8(silu4(v00), silu4(v01)); *(u32x4*)(o + 128) = pack8(silu4(v10), silu4(v11)); }
                } else {
                    const int col = 128 * (pn - 21) + cl;
                    f32x4 r0, r1, s0, s1;
#pragma unroll
                    for (int e = 0; e < 4; ++e) { const float ea0 = __expf(-v00[e]), eb0 = __expf(-v10[e]), ea1 = __expf(-v01[e]), eb1 = __expf(-v11[e]);
                        s0[e] = __builtin_amdgcn_rcpf(1.f + eb0); s1[e] = __builtin_amdgcn_rcpf(1.f + eb1);
                        r0[e] = (1.f + eb0) * __builtin_amdgcn_rcpf(1.f + ea0); r1[e] = (1.f + eb1) * __builtin_amdgcn_rcpf(1.f + ea1); }
                    if (ok) { const unsigned o = (unsigned)(row * DM + col) * 2u; *(u32x4*)boff(MGR, o) = pack8(r0, r1); *(u32x4*)boff(MGB, o) = pack8(s0, s1); }
                }
            }
    }
};
struct EpiMid {
    static constexpr bool PERM = true, AFTER_DRAIN = false, MID = true;
    unsigned char* ws; float* out;
    __device__ __forceinline__ void mid(f32x4 (&acc)[2][2][4][2], const pg8::Unit& u, int wr, int wc, int fr, int fq) const {
        asm volatile("" : "+v"(fr), "+v"(fq));
        const bf16_t* MGR = (const bf16_t*)out;
        const int cl = u.pn * 256 + wc * 32 + 8 * fq;
#pragma unroll
        for (int am = 0; am < 4; ++am) { const int ai = am >> 1, m0 = (am & 1) * 2;
            u32x4 rv[2][2];
#pragma unroll
            for (int m = 0; m < 2; ++m)
#pragma unroll
                for (int bj = 0; bj < 2; ++bj) rv[m][bj] = *(const u32x4*)boff(MGR, (unsigned)((u.pm * 256 + ai * 128 + wr * 64 + (m0 + m) * 16 + fr) * DM + cl + 128 * bj) * 2u);
#pragma unroll
            for (int m = 0; m < 2; ++m)
#pragma unroll
                for (int bj = 0; bj < 2; ++bj) { f32x4 a, b; unpack8(rv[m][bj], a, b); acc[ai][bj][m0 + m][0] *= a; acc[ai][bj][m0 + m][1] *= b; }
            asm volatile("" ::: "memory");
        }
    }
    __device__ __forceinline__ void operator()(const f32x4 (&acc)[2][2][4][2], const pg8::Unit& u, int wr, int wc, int fr, int fq) const {
        const bf16_t* MGB = (const bf16_t*)out + (size_t)MR * DM; bf16_t* Y = (bf16_t*)(ws + WS_U);
        const int cl = u.pn * 256 + wc * 32 + 8 * fq;
#pragma unroll
        for (int ai = 0; ai < 2; ++ai) {
            u32x4 bv[4][2];
#pragma unroll
            for (int m = 0; m < 4; ++m)
#pragma unroll
                for (int bj = 0; bj < 2; ++bj) bv[m][bj] = *(const u32x4*)boff(MGB, (unsigned)((u.pm * 256 + ai * 128 + wr * 64 + m * 16 + fr) * DM + cl + 128 * bj) * 2u);
#pragma unroll
            for (int m = 0; m < 4; ++m)
#pragma unroll
                for (int bj = 0; bj < 2; ++bj) { f32x4 a, b; unpack8(bv[m][bj], a, b);
                    *(u32x4*)boff(Y, (unsigned)((u.pm * 256 + ai * 128 + wr * 64 + m * 16 + fr) * DM + cl + 128 * bj) * 2u) = pack8(acc[ai][bj][m][0] * a, acc[ai][bj][m][1] * b); }
        }
    }
};
struct EpiOut {
    static constexpr bool PERM = true, AFTER_DRAIN = false, MID = false;
    const float *xp, *xs; const float* gnext; unsigned char* ws; float* out; int layer; int sqi; int fuse;
    __device__ __forceinline__ void operator()(f32x4 (&acc)[2][2][4][2], const pg8::Unit& u, int wr, int wc, int fr, int fq) const {
        bf16_t* D1 = (bf16_t*)(ws + WS_D1); bf16_t* XN = (bf16_t*)(ws + WS_XN); float* sumsq_out = (float*)(ws + WS_SUMSQ) + sqi * MPAD;
        const int cl = u.pn * 256 + wc * 32 + 8 * fq;
        f32x4 gg[2][2];
#pragma unroll
        for (int bj = 0; bj < 2; ++bj) { gg[bj][0] = *(const f32x4*)(gnext + cl + 128 * bj); gg[bj][1] = *(const f32x4*)(gnext + cl + 128 * bj + 4); }
#pragma unroll
        for (int am = 0; am < 4; ++am) { const int ai = am >> 1, m0 = (am & 1) * 2;
            f32x4 xv[2][2][2]; u32x4 dv[2][2];
#pragma unroll
            for (int m = 0; m < 2; ++m) {
                const unsigned ro = (unsigned)((u.pm * 256 + ai * 128 + wr * 64 + (m0 + m) * 16 + fr) * DM + cl);
#pragma unroll
                for (int bj = 0; bj < 2; ++bj) { const float* xr_ = boff(xp, (ro + 128u * bj) * 4u); xv[m][bj][0] = *(const f32x4*)xr_; xv[m][bj][1] = *(const f32x4*)(xr_ + 4);
                    if (layer != 0) dv[m][bj] = *(const u32x4*)boff(D1, (ro + 128u * bj) * 2u); }
            }
#pragma unroll
            for (int m = 0; m < 2; ++m) {
                const int row = u.pm * 256 + ai * 128 + wr * 64 + (m0 + m) * 16 + fr;
                const unsigned ro = (unsigned)(row * DM + cl);
                float s = 0.f;
#pragma unroll
                for (int bj = 0; bj < 2; ++bj) {
                    const unsigned o2 = (ro + 128u * bj) * 2u;
                    f32x4 x0 = xv[m][bj][0], x1 = xv[m][bj][1];
                    const f32x4 a0 = acc[ai][bj][m0 + m][0], a1 = acc[ai][bj][m0 + m][1];
                    if (layer == 0) {
                        x0 += a0; x1 += a1;
                        *(u32x4*)boff(D1, o2) = pack8(a0, a1);
                        *(u32x4*)boff(XN, o2) = pack8(x0 * gg[bj][0], x1 * gg[bj][1]);
                    } else {
                        f32x4 d0, d1; unpack8(dv[m][bj], d0, d1);
                        x0 += d0 + a0; x1 += d1 + a1;
                        if (fuse) { acc[ai][bj][m0 + m][0] = x0; acc[ai][bj][m0 + m][1] = x1; }
                        else { float* o_ = boff(out, 2u * o2); *(f32x4*)o_ = x0; *(f32x4*)(o_ + 4) = x1; }
                    }
                    s += (x0[0] * x0[0] + x0[1] * x0[1]) + (x0[2] * x0[2] + x0[3] * x0[3]) + (x1[0] * x1[0] + x1[1] * x1[1]) + (x1[2] * x1[2] + x1[3] * x1[3]);
                }
                s += swz_xor<16>(s); s = sum_x32(s);
                if (fq == 0) atomicAdd(boff(sumsq_out, (unsigned)row * 4u), s);
            }
        }
        if (layer != 0 && fuse) {
            unsigned* cnt = (unsigned*)(ws + WS_CNT) + 32 * u.pm;
            asm volatile("s_waitcnt vmcnt(0)" ::: "memory");
            if (fr == 0 && fq == 0) __hip_atomic_fetch_add(cnt, 1u, __ATOMIC_RELAXED, __HIP_MEMORY_SCOPE_AGENT);
            for (unsigned sp = 0; sp < (1u << 22); ++sp) {
                if ((unsigned)__builtin_amdgcn_readfirstlane((int)__hip_atomic_load(cnt, __ATOMIC_RELAXED, __HIP_MEMORY_SCOPE_AGENT)) >= 32u) break;
                __builtin_amdgcn_s_sleep(2);
            }
            __builtin_amdgcn_fence(__ATOMIC_ACQUIRE, "agent");
#pragma unroll
            for (int ai = 0; ai < 2; ++ai)
#pragma unroll
                for (int m = 0; m < 4; ++m) {
                    const int row = u.pm * 256 + ai * 128 + wr * 64 + m * 16 + fr;
                    const float rs = rsqrtf(__hip_atomic_load(boff(sumsq_out, (unsigned)row * 4u), __ATOMIC_RELAXED, __HIP_MEMORY_SCOPE_AGENT) * (1.0f / DM) + EPS);
#pragma unroll
                    for (int bj = 0; bj < 2; ++bj) { float* o_ = boff(out, (unsigned)(row * DM + cl + 128 * bj) * 4u);
                        *(f32x4*)o_ = acc[ai][bj][m][0] * rs * gg[bj][0]; *(f32x4*)(o_ + 4) = acc[ai][bj][m][1] * rs * gg[bj][1]; }
                }
        }
    }
};
struct TrDesc { const float* W; bf16_t* WT; int N, pitch, coff, k0, n0, drow0; };
__device__ __forceinline__ void tr_load(const TrDesc& d, float (&tv)[32], int lane) {
#pragma unroll
    for (int i = 0; i < 32; ++i) { const int kk = 2 * i + (lane >> 5); tv[i] = d.W[(size_t)(d.k0 + kk) * d.N + d.n0 + (lane & 31)]; }
}
__device__ __forceinline__ void tr_store(const TrDesc& d, const float (&tv)[32], LAS float* scr, int lane) {
#pragma unroll
    for (int i = 0; i < 32; ++i) { const int kk = 2 * i + (lane >> 5); scr[kk * 33 + (lane & 31)] = tv[i]; }
    asm volatile("s_waitcnt lgkmcnt(0)" ::: "memory");
    const int c = lane & 7;
#pragma unroll
    for (int j = 0; j < 4; ++j) { const int n = (lane >> 3) + 8 * j; const LAS float* sp = scr + (8 * c) * 33 + n;
        u32x4 o; o.x = pk2(sp[0 * 33], sp[1 * 33]); o.y = pk2(sp[2 * 33], sp[3 * 33]); o.z = pk2(sp[4 * 33], sp[5 * 33]); o.w = pk2(sp[6 * 33], sp[7 * 33]);
        *(u32x4*)(d.WT + (size_t)(d.drow0 + n) * d.pitch + d.coff + d.k0 + 8 * c) = o; }
    asm volatile("s_waitcnt lgkmcnt(0)" ::: "memory");
}
__device__ __forceinline__ int win_dst_row(int src) {
    if (src < 2048) { const int half = src >> 10, c = src & 1023; return (c >> 7) * 256 + half * 128 + (c & 127); }
    if (src < 5376) return src;
    const int s = src - 5376, half = s >> 10, c = s & 1023; return 5376 + (c >> 7) * 256 + half * 128 + (c & 127);
}

constexpr int TR_I_IN = 16 * (INC / 32), TR_I_SQ = 16 * 32, TR_I_L = TR_I_IN + 3 * TR_I_SQ;
__device__ __forceinline__ TrDesc tr_decode(int l, int r, const float* w_in, const float* w_c, const float* w_a, const float* w_o, unsigned char* ws) {
    bf16_t* WIN = (bf16_t*)(ws + WS_WIN); bf16_t* WCA = (bf16_t*)(ws + WS_WCA); bf16_t* WO = (bf16_t*)(ws + WS_WO);
    TrDesc d;
    if (r < TR_I_IN) { const int kb = r / (INC / 32), nb = r % (INC / 32); d.W = w_in + (size_t)l * DM * INC; d.WT = WIN + (size_t)l * INC * DM; d.N = INC; d.pitch = DM; d.coff = 0; d.k0 = 64 * kb; d.n0 = 32 * nb; d.drow0 = win_dst_row(32 * nb); return d; }
    r -= TR_I_IN; const int which = r / TR_I_SQ; r %= TR_I_SQ; const int kb = r / 32, nb = r % 32;
    d.N = DM; d.k0 = 64 * kb; d.n0 = 32 * nb; d.drow0 = 32 * nb; d.coff = 0;
    if (which == 0) { d.W = w_c + (size_t)l * DM * DM; d.WT = WCA + (size_t)l * DM * 2048; d.pitch = 2048; }
    else if (which == 1) { d.W = w_a + (size_t)l * DM * DM; d.WT = WCA + (size_t)l * DM * 2048; d.pitch = 2048; d.coff = 1024; }
    else { d.W = w_o + (size_t)l * DM * DM; d.WT = WO + (size_t)l * DM * DM; d.pitch = DM; }
    return d;
}
template <int N> __device__ __forceinline__ void block_sums(float (&v)[N], LAS float* red  , int tid, int lane, int wave) {
    if constexpr (N == 32) {
#define BS_STEP(HALF, MASK, XCH) { const bool up = (lane & MASK) != 0; \
        _Pragma("unroll") for (int i = 0; i < HALF; ++i) { float lo_ = v[i], hi_ = v[i + HALF]; asm volatile("" : "+v"(lo_), "+v"(hi_));   \
            const float keep = up ? hi_ : lo_, send = up ? lo_ : hi_; v[i] = keep + XCH; } }
        BS_STEP(16, 32, get_x32(send, up)) BS_STEP(8, 16, swz_xor<16>(send)) BS_STEP(4, 8, swz_xor<8>(send)) BS_STEP(2, 4, swz_xor<4>(send)) BS_STEP(1, 2, swz_xor<2>(send))
#undef BS_STEP
        v[0] += swz_xor<1>(v[0]);
        if ((lane & 1) == 0) red[wave * 32 + (lane >> 1)] = v[0];
    } else {
#pragma unroll
        for (int i = 0; i < N; ++i) { v[i] = wave_sum(v[i]); if (lane == 0) red[wave * N + i] = v[i]; }
    }
    __syncthreads();
    if (tid < N) { float t = 0.f;
#pragma unroll
        for (int w = 0; w < 8; ++w) t += red[w * N + tid];
        red[8 * N + tid] = t; }
    __syncthreads();
}

__device__ __forceinline__ void conv_tile(int tile, LAS unsigned char* lds, const bf16_t* U, const bf16_t* GA, bf16_t* CO, const f32x2 (&w)[31], const float* cb, const float* lng, const float* lnb, int tid, int lane, int wave) {
    LAS float* red = (LAS float*)lds;
    const int row0 = tile * 16, pos0 = row0 & (SEQ - 1), c0 = 2 * tid;
    f32x2 acc[16];
    { const f32x2 bias = *(const f32x2*)(cb + c0);
#pragma unroll
      for (int t = 0; t < 16; ++t) acc[t] = bias; }
    unsigned uw[46], gw[16];
#pragma unroll
    for (int i = 0; i < 46; ++i) { const bool valid = (pos0 - 30 + i) >= 0; const int ri = valid ? row0 - 30 + i : row0;
        uw[i] = *(const unsigned*)boff(U + (size_t)ri * DM, (unsigned)c0 * 2u); }
#pragma unroll
    for (int i = 0; i < 46; ++i) {
        const bool valid = (pos0 - 30 + i) >= 0; const unsigned uu = valid ? uw[i] : 0u;
        const f32x2 uv = {bf_lo(uu), bf_hi(uu)};
#pragma unroll
        for (int t = 0; t < 16; ++t) { const int j = i - t; if (j >= 0 && j <= 30) acc[t] += w[j] * uv; }
    }
#pragma unroll
    for (int t = 0; t < 16; ++t) gw[t] = *(const unsigned*)boff(GA + (size_t)(row0 + t) * DM, (unsigned)c0 * 2u);
    float v[32];
#pragma unroll
    for (int t = 0; t < 16; ++t) { v[t] = acc[t].x + acc[t].y; v[16 + t] = acc[t].x * acc[t].x + acc[t].y * acc[t].y; }
    __syncthreads();
    block_sums<32>(v, red, tid, lane, wave);
    const f32x2 g = *(const f32x2*)(lng + c0), be = *(const f32x2*)(lnb + c0);
#pragma unroll
    for (int t = 0; t < 16; ++t) {
        const float mean = red[256 + t] * (1.0f / DM), var = red[256 + 16 + t] * (1.0f / DM) - mean * mean, rstd = rsqrtf(fmaxf(var, 0.f) + EPS);
        const float y0 = (acc[t].x - mean) * rstd * g.x + be.x, y1 = (acc[t].y - mean) * rstd * g.y + be.y;
        *(unsigned*)boff(CO + (size_t)(row0 + t) * DM, (unsigned)c0 * 2u) = pk2(siluf_(y0) * bf_lo(gw[t]), siluf_(y1) * bf_hi(gw[t]));
    }
}
__device__ __forceinline__ void conv_sample(int b, int l, LAS unsigned char* lds, const float* state, float* ncs, const bf16_t* GA, bf16_t* CO, const float* cw, const float* cb, const float* lng, const float* lnb, int tid, int lane, int wave) {
    tid = fresh_tid(wave); asm volatile("" : "+v"(tid)); lane = tid & 63;
    LAS float* red = (LAS float*)lds;
    const int c0 = 2 * tid, row = MP + b;
    f32x2 acc = *(const f32x2*)(cb + c0);
    const float* st = state + ((size_t)(l * 128 + b) * 30) * DM + c0;
    float* no = ncs + (size_t)b * 30 * DM + c0;
    f32x2 sv[31], wv[31];
#pragma unroll
    for (int j = 0; j < 30; ++j) sv[j] = *(const f32x2*)(st + (size_t)j * DM);
    sv[30] = *(const f32x2*)(no + (size_t)29 * DM);
#pragma unroll
    for (int j = 0; j < 31; ++j) wv[j] = *(const f32x2*)(cw + j * DM + c0);
    const unsigned gw = *(const unsigned*)(GA + (size_t)row * DM + c0);
#pragma unroll
    for (int j = 0; j < 31; ++j) acc += wv[j] * sv[j];
#pragma unroll
    for (int j = 1; j < 30; ++j) *(f32x2*)(no + (size_t)(j - 1) * DM) = sv[j];
    float v[2] = {acc.x + acc.y, acc.x * acc.x + acc.y * acc.y};
    __syncthreads();
    block_sums<2>(v, red, tid, lane, wave);
    const float mean = red[16] * (1.0f / DM), var = red[17] * (1.0f / DM) - mean * mean, rstd = rsqrtf(fmaxf(var, 0.f) + EPS);
    const f32x2 g = *(const f32x2*)(lng + c0), be = *(const f32x2*)(lnb + c0);
    const float y0 = (acc.x - mean) * rstd * g.x + be.x, y1 = (acc.y - mean) * rstd * g.y + be.y;
    *(unsigned*)(CO + (size_t)row * DM + c0) = pk2(siluf_(y0) * bf_lo(gw), siluf_(y1) * bf_hi(gw));
}
__device__ __forceinline__ int crow(int r, int hi) { return (r & 3) + 8 * (r >> 2) + 4 * hi; }
constexpr int AT_K = 0, AT_V = 192 * 144, AT_VP = 392, AT_STG = AT_V + 64 * AT_VP, AT_WS = AT_STG + 8 * 4096, AT_END = AT_WS + 8 * 128;
constexpr int AT_NK = 192;
__device__ __forceinline__ void attn_prompt_unit(int item, LAS unsigned char* lds, const bf16_t* KV, const bf16_t* Q, bf16_t* OG, const bf16_t* GB, const float* sinks, int tid, int lane, int wave) {
    tid = fresh_tid(wave); asm volatile("" : "+v"(tid)); lane = tid & 63;
    const int g = item & 1, bq = item >> 1, row0 = bq * 64, p0 = row0 & (SEQ - 1);
    const int q = lane & 31, hi = lane >> 5, h = 8 * g + wave;
    __syncthreads();
    u32x4 kk3[3], vv3[3];
#pragma unroll
    for (int i3 = 0; i3 < 3; ++i3) { const int c = tid + 512 * i3, kc = c >> 3, ch = c & 7;
        kk3[i3] = (u32x4){0u, 0u, 0u, 0u}; vv3[i3] = (u32x4){0u, 0u, 0u, 0u};
        if (p0 - 128 + kc >= 0) { const bf16_t* src = KV + (size_t)(row0 - 128 + kc) * 256 + g * 64 + ch * 8; kk3[i3] = *(const u32x4*)src; vv3[i3] = *(const u32x4*)(src + 128); } }
    bf16x8 qf[2][4];
    { const bf16_t* qrow = Q + (size_t)(row0 + q) * DM + 64 * h;
#pragma unroll
      for (int s = 0; s < 4; ++s) qf[0][s] = *(const bf16x8*)(qrow + 16 * s + 8 * hi); }
#pragma unroll
    for (int i3 = 0; i3 < 3; ++i3) {
        const int c = tid + 512 * i3, kc = c >> 3, ch = c & 7;
        const u32x4 kk = kk3[i3], vv = vv3[i3];
        *(LAS u32x4*)(lds + AT_K + kc * 144 + ch * 16) = kk;
        LAS unsigned short* vt = (LAS unsigned short*)(lds + AT_V + (ch * 8) * AT_VP + kc * 2);
        vt[0 * (AT_VP / 2)] = (unsigned short)(vv.x & 0xffffu); vt[1 * (AT_VP / 2)] = (unsigned short)(vv.x >> 16);
        vt[2 * (AT_VP / 2)] = (unsigned short)(vv.y & 0xffffu); vt[3 * (AT_VP / 2)] = (unsigned short)(vv.y >> 16);
        vt[4 * (AT_VP / 2)] = (unsigned short)(vv.z & 0xffffu); vt[5 * (AT_VP / 2)] = (unsigned short)(vv.z >> 16);
        vt[6 * (AT_VP / 2)] = (unsigned short)(vv.w & 0xffffu); vt[7 * (AT_VP / 2)] = (unsigned short)(vv.w >> 16);
    }
    const float sink = sinks[h];
    __syncthreads();
#pragma unroll
    for (int sb = 0; sb < 2; ++sb) {
    const int p0s = p0 + 32 * sb;
    f32x16 st[5];
#pragma unroll
    for (int c = 0; c < 5; ++c) {
#pragma unroll
        for (int r = 0; r < 16; ++r) st[c][r] = 0.f;
#pragma unroll
        for (int s = 0; s < 4; ++s) { const bf16x8 kf = *(const LAS bf16x8*)(lds + AT_K + (32 * c + 32 * sb + q) * 144 + 32 * s + 16 * hi); st[c] = __builtin_amdgcn_mfma_f32_32x32x16_bf16(kf, qf[sb][s], st[c], 0, 0, 0); }
        asm volatile("" ::: "memory");
    }
    if (sb == 0) { const bf16_t* qrow = Q + (size_t)(row0 + 32 + q) * DM + 64 * h;
#pragma unroll
      for (int s = 0; s < 4; ++s) qf[1][s] = *(const bf16x8*)(qrow + 16 * s + 8 * hi); }
    u32x4 gv4[4];
#pragma unroll
    for (int i = 0; i < 4; ++i) gv4[i] = *(const u32x4*)(GB + (size_t)(row0 + 32 * sb + i * 8 + (lane >> 3)) * DM + 64 * h + (lane & 7) * 8);
    float mx = -1e30f;
    if (p0s >= 128) {
#pragma unroll
        for (int r = 0; r < 16; ++r) { const int kc = crow(r, hi); if (!(kc > q)) st[0][r] = -1e30f; if (!(kc <= q)) st[4][r] = -1e30f; }
    } else {
#pragma unroll
        for (int c = 0; c < 5; ++c)
#pragma unroll
            for (int r = 0; r < 16; ++r) { const int kc = 32 * c + crow(r, hi); const bool valid = (kc > q) && (kc <= q + 128) && (kc >= 128 - p0s); if (!valid) st[c][r] = -1e30f; }
    }
#pragma unroll
    for (int c = 0; c < 5; ++c)
#pragma unroll
        for (int r = 0; r < 16; ++r) mx = fmaxf(mx, st[c][r]);
    mx = max_x32(mx);
    const float sink2 = sink * LOG2E;
    const float mm = fmaxf(mx, sink2);
    float ls = 0.f;
#pragma unroll
    for (int c = 0; c < 5; ++c)
#pragma unroll
        for (int r = 0; r < 16; ++r) { const float p = __builtin_amdgcn_exp2f(st[c][r] - mm); st[c][r] = p; ls += p; }
    ls = sum_x32(ls);
    ls += __builtin_amdgcn_exp2f(sink2 - mm);
    f32x16 o[2];
#pragma unroll
    for (int r = 0; r < 16; ++r) { o[0][r] = 0.f; o[1][r] = 0.f; }
#pragma unroll
    for (int c = 0; c < 5; ++c)
#pragma unroll
        for (int s2 = 0; s2 < 2; ++s2) {
            u32x4 pw; pw.x = pk2(st[c][8 * s2 + 0], st[c][8 * s2 + 1]); pw.y = pk2(st[c][8 * s2 + 2], st[c][8 * s2 + 3]); pw.z = pk2(st[c][8 * s2 + 4], st[c][8 * s2 + 5]); pw.w = pk2(st[c][8 * s2 + 6], st[c][8 * s2 + 7]);
            const bf16x8 pa = __builtin_bit_cast(bf16x8, pw);
#pragma unroll
            for (int db = 0; db < 2; ++db) {
                const LAS unsigned char* vp = lds + AT_V + (q + 32 * db) * AT_VP + (32 * c + 32 * sb + 16 * s2 + 4 * hi) * 2;
                const u32x2 lo = *(const LAS u32x2*)vp, hh = *(const LAS u32x2*)(vp + 16);
                const u32x4 vw = {lo.x, lo.y, hh.x, hh.y};
                o[db] = __builtin_amdgcn_mfma_f32_32x32x16_bf16(pa, __builtin_bit_cast(bf16x8, vw), o[db], 0, 0, 0);
            }
            if (s2 == 1) asm volatile("" ::: "memory");
        }
    LAS float* wsf = (LAS float*)(lds + AT_WS + wave * 128);
    if (hi == 0) wsf[q] = __builtin_amdgcn_rcpf(ls);
    asm volatile("s_waitcnt lgkmcnt(0)" ::: "memory");
    LAS unsigned short* stg = (LAS unsigned short*)(lds + AT_STG + wave * 4096);
#pragma unroll
    for (int r = 0; r < 16; ++r) { const int qr = crow(r, hi); const float rl = wsf[qr];
        stg[qr * 64 + q] = (unsigned short)(pk2(o[0][r] * rl, 0.f) & 0xffffu); stg[qr * 64 + 32 + q] = (unsigned short)(pk2(o[1][r] * rl, 0.f) & 0xffffu); }
    asm volatile("s_waitcnt lgkmcnt(0)" ::: "memory");
#pragma unroll
    for (int i = 0; i < 4; ++i) { const int rl = i * 8 + (lane >> 3), ch = lane & 7;
        const u32x4 ov = *(const LAS u32x4*)(stg + rl * 64 + ch * 8);
        const size_t off = (size_t)(row0 + 32 * sb + rl) * DM + 64 * h + ch * 8;
        f32x4 a0, a1, g0, g1; unpack8(ov, a0, a1); unpack8(gv4[i], g0, g1);
        *(u32x4*)(OG + off) = pack8(a0 * g0, a1 * g1); }
    }
}
__device__ __forceinline__ void attn_sample_unit(int item, int l, LAS unsigned char* lds, const float* ck, const float* cv, float* nks, float* nvs, const bf16_t* Q, bf16_t* OG, const bf16_t* GB, const float* sinks, int tid, int lane, int wave) {
    tid = fresh_tid(wave); asm volatile("" : "+v"(tid)); lane = tid & 63;
    const int g = item & 1, b = item >> 1, row = MP + b, h = 8 * g + wave;
    LAS float* Kc = (LAS float*)lds; LAS float* Vc = Kc + 128 * 65;
    __syncthreads();
    f32x4 k4[4], v4[4];
#pragma unroll
    for (int i = 0; i < 4; ++i) { const int e = tid + 512 * i, w = e >> 4, d = (e & 15) * 4;
        const size_t oo = ((size_t)(b * 128 + w) * 128) + g * 64 + d, ci = ((size_t)((l * 128 + b) * 128 + w + 1) * 128) + g * 64 + d;
        if (w < 127) { k4[i] = *(const f32x4*)(ck + ci); v4[i] = *(const f32x4*)(cv + ci); } else { k4[i] = *(const f32x4*)(nks + oo); v4[i] = *(const f32x4*)(nvs + oo); } }
#pragma unroll
    for (int i = 0; i < 4; ++i) { const int e = tid + 512 * i, w = e >> 4, d = (e & 15) * 4;
        const size_t oo = ((size_t)(b * 128 + w) * 128) + g * 64 + d;
        if (w < 127) { *(f32x4*)(nks + oo) = k4[i]; *(f32x4*)(nvs + oo) = v4[i]; }
#pragma unroll
        for (int q4 = 0; q4 < 4; ++q4) { Kc[w * 65 + d + q4] = k4[i][q4]; Vc[w * 65 + d + q4] = v4[i][q4]; } }
    const size_t qoff = (size_t)row * DM + 64 * h + lane;
    const float qv = __uint_as_float((unsigned)Q[qoff] << 16);
    const float sink = sinks[h];
    __syncthreads();
    float s0 = 0.f, s1 = 0.f;
#pragma unroll
    for (int d = 0; d < 64; ++d) { const float qd = rdlane(qv, d); s0 += qd * Kc[lane * 65 + d]; s1 += qd * Kc[(lane + 64) * 65 + d]; }
    const float sink2 = sink * LOG2E;
    const float mm = fmaxf(wave_max(fmaxf(s0, s1)), sink2);
    const float p0 = __builtin_amdgcn_exp2f(s0 - mm), p1 = __builtin_amdgcn_exp2f(s1 - mm);
    const float ls = wave_sum(p0 + p1) + __builtin_amdgcn_exp2f(sink2 - mm);
    float o = 0.f;
#pragma unroll
    for (int k = 0; k < 64; ++k) o += rdlane(p0, k) * Vc[k * 65 + lane];
#pragma unroll
    for (int k = 0; k < 64; ++k) o += rdlane(p1, k) * Vc[(64 + k) * 65 + lane];
    o *= __builtin_amdgcn_rcpf(ls);
    const float gbv = __uint_as_float((unsigned)GB[qoff] << 16);
    OG[qoff] = (bf16_t)(pk2(o * gbv, 0.f) & 0xffffu);
}


typedef float f32x4s __attribute__((ext_vector_type(4)));
template <int KTOT, int MODE>
__device__ __forceinline__ void sample_gemm(int bid, int G, LAS unsigned char* lds, const bf16_t* A1, const bf16_t* A2, const bf16_t* Bt, unsigned char* ws, float* out,
                                            const float* xs, const float* gnext, int layer, int tid_) {
    int tid = tid_; asm volatile("" : "+v"(tid));
    const int lane = tid & 63, wave = __builtin_amdgcn_readfirstlane(tid >> 6), fr = lane & 15, fq = lane >> 4, kq = wave & 3;
    LAS f32x4s* red = (LAS f32x4s*)lds;
    constexpr int KQ = KTOT / 4, NS = KQ / 32;
    for (int tp = bid; tp < 256; tp += G) {
        const int tile = 2 * tp + (wave >> 2), rt = tile & 7, ct = tile >> 3;
        const int k0 = kq * KQ;
        const bf16_t* ap = (KTOT == 2048 && k0 >= 1024) ? A2 + (size_t)(MP + 16 * rt + fr) * DM + (k0 - 1024) + 8 * fq : A1 + (size_t)(MP + 16 * rt + fr) * DM + k0 + 8 * fq;
        const bf16_t* bp = Bt + (size_t)(16 * ct + fr) * KTOT + k0 + 8 * fq;
        bf16x8 af[NS], bfr[NS];
#pragma unroll
        for (int s2 = 0; s2 < NS; ++s2) { af[s2] = *(const bf16x8*)(ap + 32 * s2); bfr[s2] = *(const bf16x8*)(bp + 32 * s2); }
        const int row = MP + 16 * rt + fr, col = 16 * ct + 4 * fq;
        const unsigned o2 = (unsigned)(row * DM + col) * 2u;
        u32x2 pre0 = {0u, 0u}, pre1 = {0u, 0u}; f32x4s prex = {0.f, 0.f, 0.f, 0.f}, preg = {0.f, 0.f, 0.f, 0.f};
        if (kq == 0) {
            if constexpr (MODE == 0) { pre0 = *(const u32x2*)boff((const bf16_t*)out, o2); pre1 = *(const u32x2*)boff((const bf16_t*)out + (size_t)MR * DM, o2); }
            else { prex = *(const f32x4s*)(xs + (size_t)(row - MP) * DM + col); if (layer == 0) preg = *(const f32x4s*)(gnext + col); else pre0 = *(const u32x2*)boff((const bf16_t*)(ws + WS_D1), o2); }
        }
        f32x4s acc = {0.f, 0.f, 0.f, 0.f};
#pragma unroll
        for (int s2 = 0; s2 < NS; ++s2) acc = __builtin_amdgcn_mfma_f32_16x16x32_bf16(bfr[s2], af[s2], acc, 0, 0, 0);
        __syncthreads();
        red[((wave >> 2) * 4 + kq) * 64 + lane] = acc;
        __syncthreads();
        if (kq == 0) {
            const f32x4s p0 = red[((wave >> 2) * 4 + 0) * 64 + lane], p1 = red[((wave >> 2) * 4 + 1) * 64 + lane], p2 = red[((wave >> 2) * 4 + 2) * 64 + lane], p3 = red[((wave >> 2) * 4 + 3) * 64 + lane];
            if constexpr (MODE == 0) {
                const u32x2 rw = pre0, bw = pre1;
                const f32x4s r = {bf_lo(rw.x), bf_hi(rw.x), bf_lo(rw.y), bf_hi(rw.y)}, bb = {bf_lo(bw.x), bf_hi(bw.x), bf_lo(bw.y), bf_hi(bw.y)};
                const f32x4s y = ((p0 + p1) * r + (p2 + p3)) * bb;
                u32x2 w; w.x = pk2(y[0], y[1]); w.y = pk2(y[2], y[3]);
                *(u32x2*)boff((bf16_t*)(ws + WS_U), o2) = w;
            } else {
                const f32x4s a = (p0 + p1) + (p2 + p3);
                f32x4s x = prex;
                if (layer == 0) {
                    x += a;
                    u32x2 w; w.x = pk2(a[0], a[1]); w.y = pk2(a[2], a[3]); *(u32x2*)boff((bf16_t*)(ws + WS_D1), o2) = w;
                    const f32x4s g = preg;
                    u32x2 w2; w2.x = pk2(x[0] * g[0], x[1] * g[1]); w2.y = pk2(x[2] * g[2], x[3] * g[3]); *(u32x2*)boff((bf16_t*)(ws + WS_XN), o2) = w2;
                } else {
                    const u32x2 dw = pre0;
                    x += (f32x4s){bf_lo(dw.x), bf_hi(dw.x), bf_lo(dw.y), bf_hi(dw.y)} + a;
                    *(f32x4s*)boff(out, 2u * o2) = x;
                }
                float sq = (x[0] * x[0] + x[1] * x[1]) + (x[2] * x[2] + x[3] * x[3]);
                sq += swz_xor<16>(sq); sq = sum_x32(sq);
                if (fq == 0) atomicAdd((float*)(ws + WS_SUMSQ) + (layer + 1) * MPAD + row, sq);
                if (layer != 0) { __builtin_amdgcn_fence(__ATOMIC_RELEASE, "agent"); asm volatile("s_waitcnt vmcnt(0)" ::: "memory"); if (lane == 0) __hip_atomic_fetch_add((unsigned*)(ws + WS_CNT) + 32 * (64 + rt), 1u, __ATOMIC_RELAXED, __HIP_MEMORY_SCOPE_AGENT); }
            }
        }
    }
    __syncthreads();
}

#define XB_TMO      128
#define XB_XCNT(j)  (256  + 64 * (j))
#define XB_XSUB(j)  (1280 + 64 * (j))
#define XB_XGEN(j)  (2304 + 64 * (j))
#define XB_TOP      3328
#define XB_TOPGEN   3392
#define XCD_BAR_WORDS 3456
#define XB_SPIN_CAP (1u << 18)

__device__ __forceinline__ unsigned xb_ld(unsigned* p)              { return __hip_atomic_load(p, __ATOMIC_RELAXED, __HIP_MEMORY_SCOPE_AGENT); }
__device__ __forceinline__ unsigned xb_add(unsigned* p, unsigned v) { return __hip_atomic_fetch_add(p, v, __ATOMIC_RELAXED, __HIP_MEMORY_SCOPE_AGENT); }
__device__ __forceinline__ unsigned xb_xcc_id() { return (unsigned)__builtin_amdgcn_s_getreg((3 << 11) | 20) & 0xFu; }
#define XB_SPIN(cond, bar) do { unsigned _sp = 0; while (cond) { __builtin_amdgcn_s_sleep(1); \
    if ((++_sp & 255u) == 0u) { if (xb_ld(&(bar)[XB_TMO])) break; if (_sp > XB_SPIN_CAP) { atomicAdd(&(bar)[XB_TMO], 1u); break; } } } } while (0)

struct XcdBarrier {
    unsigned* bar; unsigned x; bool w0;
    volatile LAS unsigned* st;
};

__device__ __forceinline__ XcdBarrier xcd_barrier_post(unsigned* bar, volatile LAS unsigned* st) {
    XcdBarrier b; b.bar = bar; b.x = xb_xcc_id(); b.st = st;
    if (threadIdx.x == 0) (void)xb_add(&bar[XB_XCNT(b.x)], 1u);
    return b;
}
__device__ __forceinline__ void xcd_barrier_complete(unsigned* bar, unsigned x, unsigned& nloc, unsigned& nx) {
    const unsigned G = gridDim.x * gridDim.y * gridDim.z;
    unsigned sum, cnt, mine, sp = 0u;
    for (;;) {
        sum = 0u; cnt = 0u; mine = 0u;
#pragma unroll
        for (unsigned j = 0; j < 16; ++j) { const unsigned c = xb_ld(&bar[XB_XCNT(j)]); sum += c; cnt += (c > 0u) ? 1u : 0u; mine = (j == x) ? c : mine; }
        if (sum == G) break;
        __builtin_amdgcn_s_sleep(1);
        if ((++sp & 255u) == 0u) { if (xb_ld(&bar[XB_TMO])) break; if (sp > XB_SPIN_CAP) { atomicAdd(&bar[XB_TMO], 1u); break; } }
    }
    nloc = mine > 0u ? mine : 1u; nx = cnt > 0u ? cnt : 1u;
}

__device__ __forceinline__ void xcd_barrier(const XcdBarrier& b) {
    asm volatile("s_waitcnt vmcnt(0)" ::: "memory");
    __syncthreads();
    if (b.w0 && fresh_tid(0) == 0) {
        unsigned* bar = b.bar;
        __builtin_amdgcn_s_waitcnt(0);
        unsigned nloc = b.st[0], nx = b.st[1];
        if (nloc == 0u) { xcd_barrier_complete(bar, b.x, nloc, nx); b.st[0] = nloc; b.st[1] = nx; }
        const unsigned old = xb_add(&bar[XB_XSUB(b.x)], 1u);
        const unsigned gen = old / nloc;
        if (old + 1u == (gen + 1u) * nloc) {
            __builtin_amdgcn_fence(__ATOMIC_RELEASE, "agent");
            asm volatile("s_waitcnt vmcnt(0)" ::: "memory");
            const unsigned og = xb_add(&bar[XB_TOP], 1u);
            const unsigned tg = og / nx;
            if (og + 1u == (tg + 1u) * nx) xb_add(&bar[XB_TOPGEN], 1u);
            else XB_SPIN(xb_ld(&bar[XB_TOPGEN]) == tg, bar);
            __builtin_amdgcn_fence(__ATOMIC_ACQUIRE, "agent");
            xb_add(&bar[XB_XGEN(b.x)], 1u);
            asm volatile("s_waitcnt vmcnt(0)" ::: "memory");
        } else {
            XB_SPIN(xb_ld(&bar[XB_XGEN(b.x)]) == gen, bar);
            __builtin_amdgcn_fence(__ATOMIC_ACQUIRE, "agent");
            asm volatile("s_waitcnt vmcnt(0)" ::: "memory");
        }
    }
    __syncthreads();
}

struct Params { const float* in[16]; float* out; unsigned char* ws; float inv[8]; };
constexpr int LDS_BYTES = 131072 + 2048;

__global__ void __launch_bounds__(512, 2) fwd_megakernel(Params p) {
    extern __shared__ __attribute__((aligned(16))) unsigned char lds_raw[];
    LAS unsigned char* lds = (LAS unsigned char*)lds_raw;
    cg::grid_group grid = cg::this_grid();
    const int wave = __builtin_amdgcn_readfirstlane((int)threadIdx.x >> 6);
    const int G = gridDim.x, bid = blockIdx.x;
    volatile LAS unsigned* bst = (volatile LAS unsigned*)(lds + 131072 + 64);
    if (threadIdx.x < 2) bst[threadIdx.x] = 0u;
    __syncthreads();
    (void)xcd_barrier_post((unsigned*)(p.ws + WS_BAR), bst);
#define GRID_SYNC() do { XcdBarrier xb_; xb_.bar = (unsigned*)(p.ws + WS_BAR); xb_.x = xb_xcc_id(); xb_.st = (volatile LAS unsigned*)(lds + 131072 + 64); xb_.w0 = (wave == 0); xcd_barrier(xb_); } while (0)
    if (p.ws == nullptr) grid.sync();

#pragma unroll 1
    for (int rp0 = 0; rp0 < REP_P0; ++rp0) {
        if (rp0) GRID_SYNC();
        __attribute__((address_space(1))) unsigned char* wsg_ = (__attribute__((address_space(1))) unsigned char*)p.ws; __attribute__((address_space(1))) float* outg_ = (__attribute__((address_space(1))) float*)p.out;
        asm volatile("" : "+s"(wsg_), "+s"(outg_));
        unsigned char* ws = (unsigned char*)wsg_; float* out = (float*)outg_;
        int tid = threadIdx.x; asm volatile("" : "+v"(tid)); const int lane = tid & 63; (void)lane;
        float* sumsq = (float*)(ws + WS_SUMSQ); float* rope = (float*)(ws + WS_ROPE);
        bf16_t* XN = (bf16_t*)(ws + WS_XN); bf16_t* U = (bf16_t*)(ws + WS_U); bf16_t* GA = (bf16_t*)(ws + WS_GA); bf16_t* Q = (bf16_t*)(ws + WS_Q);
        bf16_t* GB = (bf16_t*)(ws + WS_GB); bf16_t* KV = (bf16_t*)(ws + WS_KV);
        bf16_t* WIN = (bf16_t*)(ws + WS_WIN); bf16_t* WCA = (bf16_t*)(ws + WS_WCA); bf16_t* WO = (bf16_t*)(ws + WS_WO);
        const float* x_p = p.in[0]; const float* x_s = p.in[1];
        (void)sumsq; (void)rope; (void)XN; (void)U; (void)GA; (void)Q; (void)GB; (void)KV; (void)WIN; (void)WCA; (void)WO; (void)x_p; (void)x_s;
        LAS float* scr = (LAS float*)(lds + wave * 16384);
        const int gw = bid * 8 + wave, NGW = G * 8;
        for (int it = gw; it < TR_I_L; it += 2 * NGW) {
            const bool two = it + NGW < TR_I_L;
            const TrDesc da = tr_decode(0, it, p.in[6], p.in[11], p.in[13], p.in[14], ws), db = tr_decode(0, two ? it + NGW : it, p.in[6], p.in[11], p.in[13], p.in[14], ws);
            float ta[32], tb[32];
            tr_load(da, ta, lane); if (two) tr_load(db, tb, lane);
            tr_store(da, ta, scr, lane); if (two) tr_store(db, tb, scr, lane);
        }
        const float* g0 = p.in[5];
        for (int m = gw; m < MR; m += 2 * NGW) {
            const int m2 = m + NGW; const bool two = m2 < MR;
            const float* xr = m < MP ? x_p + (size_t)m * DM : x_s + (size_t)(m - MP) * DM;
            const float* xr2 = !two ? xr : (m2 < MP ? x_p + (size_t)m2 * DM : x_s + (size_t)(m2 - MP) * DM);
            f32x4 va[4], vb[4];
#pragma unroll
            for (int j = 0; j < 4; ++j) { va[j] = *(const f32x4*)(xr + 256 * j + 4 * lane); vb[j] = *(const f32x4*)(xr2 + 256 * j + 4 * lane); }
            float sa = 0.f, sb = 0.f;
#pragma unroll
            for (int j = 0; j < 4; ++j) { const f32x4 gg = *(const f32x4*)(g0 + 256 * j + 4 * lane);
                sa += (va[j][0] * va[j][0] + va[j][1] * va[j][1]) + (va[j][2] * va[j][2] + va[j][3] * va[j][3]);
                sb += (vb[j][0] * vb[j][0] + vb[j][1] * vb[j][1]) + (vb[j][2] * vb[j][2] + vb[j][3] * vb[j][3]);
                u32x2 o; o.x = pk2(va[j][0] * gg[0], va[j][1] * gg[1]); o.y = pk2(va[j][2] * gg[2], va[j][3] * gg[3]); *(u32x2*)(XN + (size_t)m * DM + 256 * j + 4 * lane) = o;
                if (two) { u32x2 o2; o2.x = pk2(vb[j][0] * gg[0], vb[j][1] * gg[1]); o2.y = pk2(vb[j][2] * gg[2], vb[j][3] * gg[3]); *(u32x2*)(XN + (size_t)m2 * DM + 256 * j + 4 * lane) = o2; } }
            sa = wave_sum(sa); sb = wave_sum(sb);
            if (lane == 0) { sumsq[m] = sa; if (two) sumsq[m2] = sb; }
        }
        const int gt = bid * 512 + tid, NGT = G * 512;
        for (int i = gt; i < 3 * MPAD; i += NGT) { if (i >= MR) sumsq[i] = 0.f; }
        for (int i = gt; i < 4097 * 8; i += NGT) {
            const int pi = i >> 3, k = i & 7; const int pos = pi < SEQ ? pi : 16384;
            const float ang = (float)pos * p.inv[k];
            const double a = (double)ang, kk = __builtin_rint(a * 0.15915494309189535);
            double r = __builtin_fma(-kk, 6.283185307179586, a); r = __builtin_fma(-kk, 2.4492935982947064e-16, r);
            const double r2 = r * r; double sn = 1.0, cs = 1.0;
#pragma unroll
            for (int n = 11; n >= 1; --n) { sn = 1.0 - r2 * (1.0 / (double)((2 * n) * (2 * n + 1))) * sn; cs = 1.0 - r2 * (1.0 / (double)((2 * n - 1) * (2 * n))) * cs; }
            rope[pi * 16 + k] = (float)cs; rope[pi * 16 + 8 + k] = (float)(r * sn);
        }
    }
    GRID_SYNC();

#pragma unroll 1
    for (int l = 0; l < 2; ++l) {
        {
        __attribute__((address_space(1))) unsigned char* wsg_ = (__attribute__((address_space(1))) unsigned char*)p.ws; __attribute__((address_space(1))) float* outg_ = (__attribute__((address_space(1))) float*)p.out;
        asm volatile("" : "+s"(wsg_), "+s"(outg_));
        unsigned char* ws = (unsigned char*)wsg_; float* out = (float*)outg_;
        int tid = fresh_tid(wave); asm volatile("" : "+v"(tid)); const int lane = tid & 63; (void)lane;
        float* sumsq = (float*)(ws + WS_SUMSQ); float* rope = (float*)(ws + WS_ROPE);
        bf16_t* XN = (bf16_t*)(ws + WS_XN); bf16_t* U = (bf16_t*)(ws + WS_U); bf16_t* GA = (bf16_t*)(ws + WS_GA); bf16_t* Q = (bf16_t*)(ws + WS_Q);
        bf16_t* GB = (bf16_t*)(ws + WS_GB); bf16_t* KV = (bf16_t*)(ws + WS_KV);
        bf16_t* WIN = (bf16_t*)(ws + WS_WIN); bf16_t* WCA = (bf16_t*)(ws + WS_WCA); bf16_t* WO = (bf16_t*)(ws + WS_WO);
        const float* x_p = p.in[0]; const float* x_s = p.in[1];
        (void)sumsq; (void)rope; (void)XN; (void)U; (void)GA; (void)Q; (void)GB; (void)KV; (void)WIN; (void)WCA; (void)WO; (void)x_p; (void)x_s;
            pg8::Gemm g{XN, XN, WIN + (size_t)l * INC * DM, MPAD, INC, DM, DM, DM / 64};
            pg8::StaticOrder S; S.init(MPAD, INC, G, bid);
            EpiIn E{ws, out, l};
#ifndef SKIP_A
#pragma unroll 1
            for (int rp = 0; rp < REP_A; ++rp) { if (rp) GRID_SYNC(); pg8::gemm_phase<EpiIn, pg8::StaticOrder, true, true, false>(lds, g, S, E, wave); }
#endif
        }
        GRID_SYNC();
        {
        __attribute__((address_space(1))) unsigned char* wsg_ = (__attribute__((address_space(1))) unsigned char*)p.ws; __attribute__((address_space(1))) float* outg_ = (__attribute__((address_space(1))) float*)p.out;
        asm volatile("" : "+s"(wsg_), "+s"(outg_));
        unsigned char* ws = (unsigned char*)wsg_; float* out = (float*)outg_;
        int tid = fresh_tid(wave); asm volatile("" : "+v"(tid)); const int lane = tid & 63; (void)lane;
        float* sumsq = (float*)(ws + WS_SUMSQ); float* rope = (float*)(ws + WS_ROPE);
        bf16_t* XN = (bf16_t*)(ws + WS_XN); bf16_t* U = (bf16_t*)(ws + WS_U); bf16_t* GA = (bf16_t*)(ws + WS_GA); bf16_t* Q = (bf16_t*)(ws + WS_Q);
        bf16_t* GB = (bf16_t*)(ws + WS_GB); bf16_t* KV = (bf16_t*)(ws + WS_KV);
        bf16_t* WIN = (bf16_t*)(ws + WS_WIN); bf16_t* WCA = (bf16_t*)(ws + WS_WCA); bf16_t* WO = (bf16_t*)(ws + WS_WO);
        const float* x_p = p.in[0]; const float* x_s = p.in[1];
        (void)sumsq; (void)rope; (void)XN; (void)U; (void)GA; (void)Q; (void)GB; (void)KV; (void)WIN; (void)WCA; (void)WO; (void)x_p; (void)x_s;
            const float* cw = p.in[7] + (size_t)l * 31 * DM; const float* cb = p.in[8] + l * DM; const float* lng = p.in[9] + l * DM; const float* lnb = p.in[10] + l * DM;
            const float* sinks = p.in[12] + l * 16;
            float* ncs = out + O_NCS + (size_t)l * 128 * 30 * 1024; float* nks = out + O_NKS + (size_t)l * 128 * 128 * 128; float* nvs = out + O_NVS + (size_t)l * 128 * 128 * 128;
            if (l == 0) {
                LAS float* scr = (LAS float*)(lds + wave * 16384);
                const int ql = fresh_tid(0);
#pragma unroll 1
                for (int it = bid * 8 + wave; it < TR_I_L; it += G * 8) {
                    const TrDesc da = tr_decode(1, it, p.in[6], p.in[11], p.in[13], p.in[14], ws);
                    float ta[32];
                    tr_load(da, ta, ql); tr_store(da, ta, scr, ql);
                }
                __syncthreads();
            }
#pragma unroll 1
            for (int rpb = REP_B - 1; rpb >= 0; --rpb) {
            bf16_t* qd = rpb ? XN : Q; bf16_t* cd = rpb ? XN : GA;
#ifndef SKIP_ATT
            if (!rpb || (REP_B_MASK & 1))
            for (int gi = bid; gi < 256; gi += G) {
                const int grp = (G == 256) ? (gi & 7) * 32 + (gi >> 3) : gi;
#pragma unroll 1
                for (int k = 0; k < 2; ++k) attn_prompt_unit(((2 * (grp >> 1) + k) << 1) | (grp & 1), lds, KV, Q, qd, GB, sinks, tid, lane, wave);
            }
#endif
            if (!rpb || (REP_B_MASK & 2))
            {
                int tc = fresh_tid(wave); asm volatile("" : "+v"(tc)); const int lc = tc & 63;
                f32x2 w[31];
#pragma unroll
                for (int j = 0; j < 31; ++j) w[j] = *(const f32x2*)boff(cw + j * DM, (unsigned)tc * 8u);
                for (int gi = bid; gi < 256; gi += G) {
                    const int grp = (G == 256) ? (gi & 7) * 32 + (gi >> 3) : gi;
#pragma unroll 1
                    for (int k = 0; k < 4; ++k) conv_tile(4 * grp + k, lds, U, GA, cd, w, cb, lng, lnb, tc, lc, wave);
                }
            }
#ifndef SKIP_ATT
            if (!rpb || (REP_B_MASK & 4)) {
            for (int it = bid; it < 128; it += G) conv_sample(it, l, lds, p.in[2], ncs, GA, cd, cw, cb, lng, lnb, tid, lane, wave);
            for (int it = bid; it < 256; it += G) attn_sample_unit(it, l, lds, p.in[3], p.in[4], nks, nvs, Q, qd, GB, sinks, tid, lane, wave);
            }
#endif
            if (rpb) GRID_SYNC();
            }
        }
        GRID_SYNC();
        {
        __attribute__((address_space(1))) unsigned char* wsg_ = (__attribute__((address_space(1))) unsigned char*)p.ws; __attribute__((address_space(1))) float* outg_ = (__attribute__((address_space(1))) float*)p.out;
        asm volatile("" : "+s"(wsg_), "+s"(outg_));
        unsigned char* ws = (unsigned char*)wsg_; float* out = (float*)outg_;
        int tid = fresh_tid(wave); asm volatile("" : "+v"(tid)); const int lane = tid & 63; (void)lane;
        float* sumsq = (float*)(ws + WS_SUMSQ); float* rope = (float*)(ws + WS_ROPE);
        bf16_t* XN = (bf16_t*)(ws + WS_XN); bf16_t* U = (bf16_t*)(ws + WS_U); bf16_t* GA = (bf16_t*)(ws + WS_GA); bf16_t* Q = (bf16_t*)(ws + WS_Q);
        bf16_t* GB = (bf16_t*)(ws + WS_GB); bf16_t* KV = (bf16_t*)(ws + WS_KV);
        bf16_t* WIN = (bf16_t*)(ws + WS_WIN); bf16_t* WCA = (bf16_t*)(ws + WS_WCA); bf16_t* WO = (bf16_t*)(ws + WS_WO);
        const float* x_p = p.in[0]; const float* x_s = p.in[1];
        (void)sumsq; (void)rope; (void)XN; (void)U; (void)GA; (void)Q; (void)GB; (void)KV; (void)WIN; (void)WCA; (void)WO; (void)x_p; (void)x_s;
            pg8::Gemm g{GA, Q, WCA + (size_t)l * DM * 2048, MP, DM, 2048, DM, DM / 64};
            pg8::StaticOrder S; S.init(MP, DM, G, bid);
            sample_gemm<2048, 0>(bid, G, lds, GA, Q, WCA + (size_t)l * DM * 2048, ws, out, x_s, p.in[5] + DM, l, tid);
            EpiMid E{ws, out};
#ifndef SKIP_C
#pragma unroll 1
            for (int rp = 0; rp < REP_C; ++rp) { if (rp) GRID_SYNC(); pg8::gemm_phase<EpiMid, pg8::StaticOrder, true, true, true>(lds, g, S, E, wave); }
#endif
        }
        GRID_SYNC();
        {
        __attribute__((address_space(1))) unsigned char* wsg_ = (__attribute__((address_space(1))) unsigned char*)p.ws; __attribute__((address_space(1))) float* outg_ = (__attribute__((address_space(1))) float*)p.out;
        asm volatile("" : "+s"(wsg_), "+s"(outg_));
        unsigned char* ws = (unsigned char*)wsg_; float* out = (float*)outg_;
        int tid = fresh_tid(wave); asm volatile("" : "+v"(tid)); const int lane = tid & 63; (void)lane;
        float* sumsq = (float*)(ws + WS_SUMSQ); float* rope = (float*)(ws + WS_ROPE);
        bf16_t* XN = (bf16_t*)(ws + WS_XN); bf16_t* U = (bf16_t*)(ws + WS_U); bf16_t* GA = (bf16_t*)(ws + WS_GA); bf16_t* Q = (bf16_t*)(ws + WS_Q);
        bf16_t* GB = (bf16_t*)(ws + WS_GB); bf16_t* KV = (bf16_t*)(ws + WS_KV);
        bf16_t* WIN = (bf16_t*)(ws + WS_WIN); bf16_t* WCA = (bf16_t*)(ws + WS_WCA); bf16_t* WO = (bf16_t*)(ws + WS_WO);
        const float* x_p = p.in[0]; const float* x_s = p.in[1];
        (void)sumsq; (void)rope; (void)XN; (void)U; (void)GA; (void)Q; (void)GB; (void)KV; (void)WIN; (void)WCA; (void)WO; (void)x_p; (void)x_s;
            pg8::Gemm g{U, U, WO + (size_t)l * DM * DM, MP, DM, DM, DM, DM / 64};
            pg8::StaticOrder S; S.init(MP, DM, G, bid);
            sample_gemm<1024, 1>(bid, G, lds, U, U, WO + (size_t)l * DM * DM, ws, out, x_s, p.in[5] + DM, l, tid);
            const int fuse = (G == 256) ? 1 : 0;
            EpiOut E{x_p, x_s, l == 0 ? p.in[5] + DM : p.in[15], ws, out, l, l + 1, fuse};
#ifndef SKIP_D
#pragma unroll 1
            for (int rp = 0; rp < REP_D; ++rp) { if (rp) { GRID_SYNC(); E.sqi = 0; } pg8::gemm_phase<EpiOut, pg8::StaticOrder, true, true, true>(lds, g, S, E, wave); }
#endif
            if (l == 1 && fuse) {
                const int ql = fresh_tid(0);
                for (int r = bid * 8 + wave; r < MS; r += G * 8) {
                    unsigned* cnt = (unsigned*)(ws + WS_CNT) + 32 * (64 + (r >> 4));
                    for (unsigned sp = 0; sp < (1u << 22); ++sp) { if ((unsigned)__builtin_amdgcn_readfirstlane((int)__hip_atomic_load(cnt, __ATOMIC_RELAXED, __HIP_MEMORY_SCOPE_AGENT)) >= 64u) break; __builtin_amdgcn_s_sleep(2); }
                    __builtin_amdgcn_fence(__ATOMIC_ACQUIRE, "agent");
                    const int row = MP + r;
                    const float rs = rsqrtf(__hip_atomic_load((float*)(ws + WS_SUMSQ) + 2 * MPAD + row, __ATOMIC_RELAXED, __HIP_MEMORY_SCOPE_AGENT) * (1.0f / DM) + EPS);
                    float* orow = out + (size_t)row * DM; const float* gf = p.in[15];
#pragma unroll
                    for (int j = 0; j < 4; ++j) { const f32x4 v = *(const f32x4*)(orow + 256 * j + 4 * ql), gg = *(const f32x4*)(gf + 256 * j + 4 * ql); *(f32x4*)(orow + 256 * j + 4 * ql) = v * rs * gg; }
                }
            }
        }
        if (!(l == 1 && G == 256)) GRID_SYNC();
    }
    if (G != 256) {
        __attribute__((address_space(1))) unsigned char* wsg_ = (__attribute__((address_space(1))) unsigned char*)p.ws; __attribute__((address_space(1))) float* outg_ = (__attribute__((address_space(1))) float*)p.out;
        asm volatile("" : "+s"(wsg_), "+s"(outg_));
        unsigned char* ws = (unsigned char*)wsg_; float* out = (float*)outg_;
        int tid = fresh_tid(wave); asm volatile("" : "+v"(tid)); const int lane = tid & 63; (void)lane;
        float* sumsq = (float*)(ws + WS_SUMSQ); float* rope = (float*)(ws + WS_ROPE);
        bf16_t* XN = (bf16_t*)(ws + WS_XN); bf16_t* U = (bf16_t*)(ws + WS_U); bf16_t* GA = (bf16_t*)(ws + WS_GA); bf16_t* Q = (bf16_t*)(ws + WS_Q);
        bf16_t* GB = (bf16_t*)(ws + WS_GB); bf16_t* KV = (bf16_t*)(ws + WS_KV);
        bf16_t* WIN = (bf16_t*)(ws + WS_WIN); bf16_t* WCA = (bf16_t*)(ws + WS_WCA); bf16_t* WO = (bf16_t*)(ws + WS_WO);
        const float* x_p = p.in[0]; const float* x_s = p.in[1];
        (void)sumsq; (void)rope; (void)XN; (void)U; (void)GA; (void)Q; (void)GB; (void)KV; (void)WIN; (void)WCA; (void)WO; (void)x_p; (void)x_s;
        const float* gf = p.in[15]; const float* sq = sumsq + 2 * MPAD;
        const int gw = bid * 8 + wave, NGW = G * 8;
#pragma unroll 1
        for (int rp = REP_F - 1; rp >= 0; --rp) {
        float* dst = rp ? (float*)(ws + WS_U) : out;
        for (int m = gw; m < MR; m += 2 * NGW) {
            const int m2 = m + NGW < MR ? m + NGW : m;
            const float rs = rsqrtf(sq[m] * (1.0f / DM) + EPS), rs2 = rsqrtf(sq[m2] * (1.0f / DM) + EPS);
            const float* orow = out + (size_t)m * DM; float* drow = dst + (size_t)m * DM; const float* orow2 = out + (size_t)m2 * DM; float* drow2 = dst + (size_t)m2 * DM;
            f32x4 va[4], vb[4];
#pragma unroll
            for (int j = 0; j < 4; ++j) { va[j] = *(const f32x4*)(orow + 256 * j + 4 * lane); vb[j] = *(const f32x4*)(orow2 + 256 * j + 4 * lane); }
#pragma unroll
            for (int j = 0; j < 4; ++j) { const f32x4 gg = *(const f32x4*)(gf + 256 * j + 4 * lane); *(f32x4*)(drow + 256 * j + 4 * lane) = va[j] * rs * gg; if (m2 != m) *(f32x4*)(drow2 + 256 * j + 4 * lane) = vb[j] * rs2 * gg; }
        }
        if (rp) GRID_SYNC();
        }
    }
}

extern "C" void kernel_launch(void* const* d_in, const int* in_sizes, int n_in, void* d_out, int out_size, void* d_ws, size_t ws_size, hipStream_t stream) {
    static int grid = 0;
    if (grid == 0) {
        if (n_in != 16 || (size_t)out_size != O_END || ws_size < WS_END) { fprintf(stderr, "kernel_launch: unexpected sizes n_in %d out %d ws %zu\n", n_in, out_size, ws_size); grid = -1; return; }
        int dev = 0, cus = 0, per_cu = 0;
        hipGetDevice(&dev); hipDeviceGetAttribute(&cus, hipDeviceAttributeMultiprocessorCount, dev);
        if (hipFuncSetAttribute((const void*)fwd_megakernel, hipFuncAttributeMaxDynamicSharedMemorySize, LDS_BYTES) != hipSuccess) { fprintf(stderr, "kernel_launch: hipFuncSetAttribute failed\n"); grid = -1; return; }
        if (hipOccupancyMaxActiveBlocksPerMultiprocessor(&per_cu, (const void*)fwd_megakernel, 512, LDS_BYTES) != hipSuccess || per_cu < 1) { fprintf(stderr, "kernel_launch: occupancy query gave %d\n", per_cu); per_cu = 1; }
        (void)hipGetLastError();
        grid = cus * per_cu;
    }
    if (grid < 0) return;
    Params p{};
    for (int i = 0; i < 16; ++i) p.in[i] = (const float*)d_in[i];
    p.out = (float*)d_out; p.ws = (unsigned char*)d_ws;
    static const float inv[8] = {1.0f, 0.1939227432012558f, 0.03760603070259094f, 0.007292664609849453f, 0.0014142135623842478f, 0.00027424818836152554f, 5.3182957344688475e-05f, 1.0313385246263351e-05f};
    for (int i = 0; i < 8; ++i) p.inv[i] = inv[i];
    if (hipMemsetAsync((char*)d_ws + WS_BAR, 0, 16384 + 80 * 128, stream) != hipSuccess) { fprintf(stderr, "kernel_launch: hipMemsetAsync failed\n"); return; }
    void* args[] = {&p};
    hipError_t e = hipLaunchCooperativeKernel((const void*)fwd_megakernel, dim3(grid), dim3(512), args, LDS_BYTES, stream);
    if (e != hipSuccess) fprintf(stderr, "cooperative launch failed: %s (grid %d)\n", hipGetErrorString(e), grid);
}
```

```cpp
#include <hip/hip_runtime.h>
#include <hip/hip_cooperative_groups.h>
#include <cstdio>
#include <cstdint>
namespace cg = cooperative_groups;
#ifndef REP_A
#define REP_A 1
#endif
#ifndef REP_C
#define REP_C 1
#endif
#ifndef REP_B1
#define REP_B1 1
#endif
#ifndef REP_B2
#define REP_B2 1
#endif
#ifndef DUMMY_CONV
#define DUMMY_CONV 0
#endif
#ifndef REP_D
#define REP_D 1
#endif
#ifndef DUMMY_SAMP
#define DUMMY_SAMP 0
#endif
#ifndef REP_F
#define REP_F 1
#endif
#ifndef REP_B
#define REP_B 1
#endif
#ifndef REP_B_MASK
#define REP_B_MASK 7
#endif
#ifndef REP_P0
#define REP_P0 1
#endif

constexpr int DM = 1024, SEQ = 4096, MP = 16384, MS = 128, MR = MP + MS, MPAD = 16640, INC = 7424;
constexpr float EPS = 1e-6f;
constexpr float QSCALE = 0.125f * 1.4426950408889634f, LOG2E = 1.4426950408889634f;
constexpr size_t O_YP = 0, O_YS = (size_t)MP * DM, O_NCP = O_YS + (size_t)MS * DM, O_NKP = O_NCP + 2 * 4 * 30 * 1024, O_NVP = O_NKP + 2 * 4 * 128 * 128,
                 O_NCS = O_NVP + 2 * 4 * 128 * 128, O_NKS = O_NCS + (size_t)2 * 128 * 30 * 1024, O_NVS = O_NKS + (size_t)2 * 128 * 128 * 128, O_END = O_NVS + (size_t)2 * 128 * 128 * 128;
constexpr size_t RB = (size_t)MPAD * DM * 2;
constexpr size_t WS_SUMSQ = 0;
constexpr size_t WS_CNT = 768 * 1024 + 16384;
constexpr size_t WS_BAR = 768 * 1024;
constexpr size_t WS_ROPE = 256 * 1024;
constexpr size_t WS_XN = 1 << 20, WS_U = WS_XN + RB, WS_GA = WS_U + RB, WS_Q = WS_GA + RB, WS_GB = WS_Q + RB, WS_D1 = WS_GB + RB, WS_KV = WS_D1 + RB;
constexpr size_t WS_WIN = WS_KV + (size_t)MPAD * 256 * 2, WS_WCA = WS_WIN + (size_t)2 * INC * DM * 2, WS_WO = WS_WCA + (size_t)2 * DM * 2048 * 2, WS_END = WS_WO + (size_t)2 * DM * DM * 2;
static_assert(WS_END <= 268435456, "d_ws map exceeds 256 MiB");
static_assert(3 * MPAD * 4 <= WS_ROPE && WS_ROPE + 4097 * 16 * 4 <= WS_XN, "small regions");

__device__ __forceinline__ int fresh_tid(int wave) { int l; asm volatile("v_mbcnt_lo_u32_b32 %0, -1, 0\n\tv_mbcnt_hi_u32_b32 %0, -1, %0" : "=v"(l)); return wave * 64 + l; }
namespace pg8 {
#define PG8_LAS __attribute__((address_space(3)))
typedef unsigned short bf16_t;
typedef short bf16x8 __attribute__((ext_vector_type(8)));
typedef float f32x4 __attribute__((ext_vector_type(4)));
typedef unsigned u32x4 __attribute__((ext_vector_type(4)));
constexpr int BM = 256, BK = 64, HALF = 128, HTB = HALF * BK * 2  , STAGE_BYTES = 8 * HTB, NXCD = 8, WGM = 8;

__host__ __device__ __forceinline__ int lds_byte(int r, int c) { const int st = (r >> 4) * 2 + (c >> 5), rr = r & 15, cc = c & 31, ob = rr * 64 + cc * 2; return st * 1024 + (ob ^ (((ob >> 9) & 1) << 5)); }
__host__ __device__ __forceinline__ void stage_rc(int b, int& R, int& C) { const int st = b / 1024, sb = b % 1024, swz = sb ^ (((sb >> 9) & 1) << 5); R = (st >> 1) * 16 + swz / 64; C = (st & 1) * 32 + (swz % 64) / 2; }
__host__ __device__ __forceinline__ int perm32(int rho) { const int n = rho >> 4, i = rho & 15; return 8 * (i >> 2) + 4 * n + (i & 3); }

struct Unit { int pm, pn; };
struct Gemm { const bf16_t* A; const bf16_t* A2; const bf16_t* Bt; int M, N, K, lda, nth; };

struct StaticOrder {
    int nM, nN, nwg, G, c;
    __host__ __device__ void init(int M, int N, int G_, int c_) { nM = M / BM; nN = N / BM; nwg = nM * nN; G = G_; c = c_; }
    __host__ __device__ bool next(int i, Unit& u) const {
        const long L = (long)i * G + c; if (L >= nwg) return false;
        int wgid = (int)L; { const int q = nwg / NXCD, r = nwg % NXCD, xcd = wgid % NXCD, off = wgid / NXCD; wgid = (xcd < r ? xcd * (q + 1) : r * (q + 1) + (xcd - r) * q) + off; }
        const int nig = WGM * nN, gid = wgid / nig, fm = gid * WGM, gsz = (nM - fm) < WGM ? (nM - fm) : WGM;
        u.pm = fm + ((wgid % nig) % gsz); u.pn = (wgid % nig) / gsz; return true;
    }
    __device__ __forceinline__ void a_ready(const Unit&) const {}
    __device__ __forceinline__ void done(const Unit&) const {}
};


template <class Epi, class Sched, bool ALIGN_EPI = false, bool SP2 = false, bool LAUNDER = true>
__device__ __forceinline__ void gemm_phase(PG8_LAS unsigned char* lds, const Gemm g, const Sched& S, const Epi& E, int wave_id) {
    int tid = fresh_tid(wave_id);
    asm volatile("" : "+v"(tid));
    const int wid = __builtin_amdgcn_readfirstlane(tid >> 6), lane = tid & 63, wr = wid >> 2, wc = wid & 3, fr = lane & 15, fq = lane >> 4;
    const int K = g.K, nt = K / BK, lda = g.lda, nth = g.nth;
    unsigned voffA[2], voffB[2];
#pragma unroll
    for (int i = 0; i < 2; ++i) { int R, C; stage_rc(tid * 16 + i * 8192, R, C); const int Rb = Epi::PERM ? ((R & ~31) + perm32(R & 31)) : R;
        voffA[i] = (unsigned)(R * lda + C) * 2u; voffB[i] = (unsigned)(Rb * K + C) * 2u; }
    const size_t kstep = (size_t)(BK * 2);
    const size_t hstepB = (size_t)HALF * K * 2, hstepA = (size_t)HALF * lda * 2;
    const size_t tstepB = 2 * hstepB, tstepA = 2 * hstepA;
    const unsigned ldsw = (unsigned)wid * 1024u;
    const int aoff = lds_byte(wr * 64 + fr, fq * 8), boff = lds_byte(wc * 32 + fr, fq * 8);
#define PG8_SA(b, h) (((b) * 2 + (h)) * HTB)
#define PG8_SB(b, h) ((4 + (b) * 2 + (h)) * HTB)
#define PG8_STAGE(bufoff, gbase, voff) do { _Pragma("unroll") for (int _i = 0; _i < 2; ++_i) \
        __builtin_amdgcn_global_load_lds((const unsigned*)((const char*)(gbase) + (voff)[_i]), (PG8_LAS unsigned*)(lds + (bufoff) + ldsw + _i * 8192), 16, 0, 0); } while (0)
#define PG8_LDA(dst, b, h) do { _Pragma("unroll") for (int m = 0; m < 4; ++m) _Pragma("unroll") for (int k = 0; k < 2; ++k) dst[m][k] = *(const PG8_LAS bf16x8*)(lds + PG8_SA(b, h) + aoff + m * 2048 + k * 1024); } while (0)
#define PG8_LDB(dst, b, h) do { _Pragma("unroll") for (int n = 0; n < 2; ++n) _Pragma("unroll") for (int k = 0; k < 2; ++k) dst[n][k] = *(const PG8_LAS bf16x8*)(lds + PG8_SB(b, h) + boff + n * 2048 + k * 1024); } while (0)
#define PG8_MMA(ai, bj, At, Bt) do { __builtin_amdgcn_s_setprio(1); _Pragma("unroll") for (int m = 0; m < 4; ++m) _Pragma("unroll") for (int n = 0; n < 2; ++n) _Pragma("unroll") for (int k = 0; k < 2; ++k) \
        acc[ai][bj][m][n] = __builtin_amdgcn_mfma_f32_16x16x32_bf16(Bt[n][k], At[m][k], acc[ai][bj][m][n], 0, 0, 0); __builtin_amdgcn_s_setprio(0); } while (0)
#define PG8_WAIT_V(n) asm volatile("s_waitcnt vmcnt(" #n ")" ::: "memory")
#define PG8_WAIT_L(n) asm volatile("s_waitcnt lgkmcnt(" #n ")" ::: "memory")
#define PG8_BAR __builtin_amdgcn_s_barrier()
#define PG8_SCHED __builtin_amdgcn_sched_barrier(0)
    Unit cur, nxt; int ui = 0;
    if (!S.next(0, cur)) return;
    f32x4 acc[2][2][4][2];
#pragma unroll
    for (int a = 0; a < 2; ++a)
#pragma unroll
        for (int b = 0; b < 2; ++b)
#pragma unroll
            for (int m = 0; m < 4; ++m)
#pragma unroll
                for (int n = 0; n < 2; ++n) acc[a][b][m][n] = (f32x4){0.f, 0.f, 0.f, 0.f};
    bf16x8 At[4][2], B0[2][2], B1[2][2];
    const char* cA = (const char*)g.A + (size_t)cur.pm * tstepA; const char* cB = (const char*)g.Bt + (size_t)cur.pn * tstepB;
    S.a_ready(cur);
    if constexpr (SP2) {
        PG8_STAGE(PG8_SB(0, 0), cB, voffB); PG8_STAGE(PG8_SB(0, 1), cB + hstepB, voffB); PG8_STAGE(PG8_SA(0, 0), cA, voffA); PG8_STAGE(PG8_SA(0, 1), cA + hstepA, voffA);
        if (wr == 1) PG8_BAR;
        PG8_WAIT_V(2); PG8_BAR;
        PG8_STAGE(PG8_SB(1, 0), cB + kstep, voffB); PG8_STAGE(PG8_SA(1, 0), cA + kstep, voffA); PG8_STAGE(PG8_SB(1, 1), cB + hstepB + kstep, voffB);
        PG8_WAIT_V(6); PG8_BAR;
    } else {
        PG8_STAGE(PG8_SB(0, 0), cB, voffB); PG8_STAGE(PG8_SA(0, 0), cA, voffA); PG8_STAGE(PG8_SB(0, 1), cB + hstepB, voffB); PG8_STAGE(PG8_SA(0, 1), cA + hstepA, voffA);
        if (wr == 1) PG8_BAR;
        PG8_WAIT_V(4); PG8_BAR;
        PG8_STAGE(PG8_SB(1, 0), cB + kstep, voffB); PG8_STAGE(PG8_SA(1, 0), cA + kstep, voffA); PG8_STAGE(PG8_SB(1, 1), cB + hstepB + kstep, voffB);
        PG8_WAIT_V(6); PG8_BAR;
    }
    for (;;) {
        const bool has_next = S.next(ui + 1, nxt);
        const char* nA = has_next ? (const char*)g.A + (size_t)nxt.pm * tstepA : cA; const char* nB = has_next ? (const char*)g.Bt + (size_t)nxt.pn * tstepB : cB;
        const char* cA2 = (const char*)g.A2 + (size_t)cur.pm * tstepA - (size_t)nth * kstep;
        for (int t = 0; t < nt; t += 2) {
            const bool last = (t == nt - 2);
            if constexpr (Epi::MID) { if (t == nth) E.mid(acc, cur, wr, wc, fr, fq); }
            const char* a1 = (t < nth ? cA : cA2) + (size_t)(t + 1) * kstep;
            const char* a2 = last ? nA : (t + 2 < nth ? cA : cA2) + (size_t)(t + 2) * kstep; const char* b2 = last ? nB : cB + (size_t)(t + 2) * kstep;
            const char* a3 = a2 + kstep; const char* b3 = b2 + kstep;
            if (last && has_next) S.a_ready(nxt);
            if constexpr (SP2) {
            PG8_LDB(B0, 0, 0); PG8_LDB(B1, 0, 1); PG8_SCHED; PG8_LDA(At, 0, 0); PG8_STAGE(PG8_SA(1, 1), a1 + hstepA, voffA);
            PG8_WAIT_V(8); PG8_WAIT_L(0); PG8_BAR; PG8_MMA(0, 0, At, B0); PG8_MMA(0, 1, At, B1); PG8_BAR; PG8_SCHED;
            PG8_LDA(At, 0, 1); PG8_STAGE(PG8_SB(0, 0), b2, voffB); PG8_STAGE(PG8_SB(0, 1), b2 + hstepB, voffB); PG8_STAGE(PG8_SA(0, 0), a2, voffA);
            PG8_WAIT_V(8); PG8_WAIT_L(0); PG8_BAR; PG8_MMA(1, 0, At, B0); PG8_MMA(1, 1, At, B1); PG8_BAR; PG8_SCHED;
            PG8_LDB(B0, 1, 0); PG8_LDB(B1, 1, 1); PG8_SCHED; PG8_LDA(At, 1, 0); PG8_STAGE(PG8_SA(0, 1), a2 + hstepA, voffA);
            PG8_WAIT_V(8); PG8_WAIT_L(0); PG8_BAR; PG8_MMA(0, 0, At, B0); PG8_MMA(0, 1, At, B1); PG8_BAR; PG8_SCHED;
            PG8_LDA(At, 1, 1); PG8_STAGE(PG8_SB(1, 0), b3, voffB); PG8_STAGE(PG8_SB(1, 1), b3 + hstepB, voffB); PG8_STAGE(PG8_SA(1, 0), a3, voffA);
            PG8_WAIT_V(8); PG8_WAIT_L(0); PG8_BAR; PG8_MMA(1, 0, At, B0); PG8_MMA(1, 1, At, B1); PG8_BAR; PG8_SCHED;
            } else {
            PG8_LDB(B0, 0, 0); PG8_SCHED; PG8_LDA(At, 0, 0); PG8_STAGE(PG8_SA(1, 1), a1 + hstepA, voffA);
            PG8_WAIT_L(8); PG8_BAR; PG8_WAIT_L(0); PG8_MMA(0, 0, At, B0); PG8_BAR; PG8_SCHED;
            PG8_LDB(B1, 0, 1); PG8_STAGE(PG8_SB(0, 0), b2, voffB);
            PG8_BAR; PG8_WAIT_L(0); PG8_MMA(0, 1, At, B1); PG8_BAR;
            PG8_LDA(At, 0, 1); PG8_STAGE(PG8_SA(0, 0), a2, voffA);
            PG8_BAR; PG8_WAIT_L(0); PG8_MMA(1, 0, At, B0); PG8_BAR; PG8_SCHED;
            PG8_STAGE(PG8_SB(0, 1), b2 + hstepB, voffB);
            PG8_WAIT_V(6); PG8_BAR; PG8_MMA(1, 1, At, B1); PG8_BAR;
            PG8_LDB(B0, 1, 0); PG8_SCHED; PG8_LDA(At, 1, 0); PG8_STAGE(PG8_SA(0, 1), a2 + hstepA, voffA);
            PG8_WAIT_L(8); PG8_BAR; PG8_WAIT_L(0); PG8_MMA(0, 0, At, B0); PG8_BAR; PG8_SCHED;
            PG8_LDB(B1, 1, 1); PG8_STAGE(PG8_SB(1, 0), b3, voffB);
            PG8_BAR; PG8_WAIT_L(0); PG8_MMA(0, 1, At, B1); PG8_BAR;
            PG8_LDA(At, 1, 1); PG8_STAGE(PG8_SA(1, 0), a3, voffA);
            PG8_BAR; PG8_WAIT_L(0); PG8_MMA(1, 0, At, B0); PG8_BAR; PG8_SCHED;
            PG8_STAGE(PG8_SB(1, 1), b3 + hstepB, voffB);
            PG8_WAIT_V(6); PG8_BAR; PG8_MMA(1, 1, At, B1); PG8_BAR;
            }
        }
        if constexpr (ALIGN_EPI) { if (wr == 0) PG8_BAR; }
        if constexpr (!Epi::AFTER_DRAIN) { E(acc, cur, wr, wc, fr, fq); S.done(cur); }
        if (!has_next) break;
#pragma unroll
        for (int a = 0; a < 2; ++a)
#pragma unroll
            for (int b = 0; b < 2; ++b)
#pragma unroll
                for (int m = 0; m < 4; ++m)
#pragma unroll
                    for (int n = 0; n < 2; ++n) acc[a][b][m][n] = (f32x4){0.f, 0.f, 0.f, 0.f};
        cur = nxt; cA = nA; cB = nB; ++ui;
        if constexpr (ALIGN_EPI) { if (wr == 1) PG8_BAR; }
    }
    PG8_WAIT_V(0);
    if constexpr (!ALIGN_EPI) { if (wr == 0) PG8_BAR; }
    PG8_BAR;
    if constexpr (Epi::AFTER_DRAIN) { E.fused(acc, cur, wr, wc, fr, fq, lds, wid, lane); S.done(cur); }
#undef PG8_SA
#undef PG8_SB
#undef PG8_STAGE
#undef PG8_LDA
#undef PG8_LDB
#undef PG8_MMA
#undef PG8_WAIT_V
#undef PG8_WAIT_L
#undef PG8_BAR
#undef PG8_SCHED
}
}

#define LAS __attribute__((address_space(3)))
typedef unsigned short bf16_t;
typedef float f32x4 __attribute__((ext_vector_type(4)));
typedef float f32x2 __attribute__((ext_vector_type(2)));
typedef float f32x16 __attribute__((ext_vector_type(16)));
typedef unsigned u32x4 __attribute__((ext_vector_type(4)));
typedef unsigned u32x2 __attribute__((ext_vector_type(2)));
typedef short bf16x8 __attribute__((ext_vector_type(8)));
typedef __bf16 bf16x2_t __attribute__((ext_vector_type(2)));
template <class T> __device__ __forceinline__ T* boff(T* base, unsigned bytes) { return (T*)((char*)base + bytes); }
template <class T> __device__ __forceinline__ const T* boff(const T* base, unsigned bytes) { return (const T*)((const char*)base + bytes); }
__device__ __forceinline__ unsigned pk2(float lo, float hi) { f32x2 v = {lo, hi}; bf16x2_t b = __builtin_convertvector(v, bf16x2_t); return __builtin_bit_cast(unsigned, b); }
__device__ __forceinline__ u32x4 pack8(f32x4 a, f32x4 b) { u32x4 w; w.x = pk2(a[0], a[1]); w.y = pk2(a[2], a[3]); w.z = pk2(b[0], b[1]); w.w = pk2(b[2], b[3]); return w; }
__device__ __forceinline__ float bf_lo(unsigned w) { return __uint_as_float(w << 16); }
__device__ __forceinline__ float bf_hi(unsigned w) { return __uint_as_float(w & 0xffff0000u); }
__device__ __forceinline__ void unpack8(u32x4 w, f32x4& a, f32x4& b) { a = (f32x4){bf_lo(w.x), bf_hi(w.x), bf_lo(w.y), bf_hi(w.y)}; b = (f32x4){bf_lo(w.z), bf_hi(w.z), bf_lo(w.w), bf_hi(w.w)}; }
__device__ __forceinline__ float sigmoidf_(float x) { return __builtin_amdgcn_rcpf(1.0f + __expf(-x)); }
__device__ __forceinline__ float siluf_(float x) { return x * sigmoidf_(x); }
__device__ __forceinline__ f32x4 sig4(f32x4 v) { return (f32x4){sigmoidf_(v[0]), sigmoidf_(v[1]), sigmoidf_(v[2]), sigmoidf_(v[3])}; }
__device__ __forceinline__ f32x4 silu4(f32x4 v) { return (f32x4){siluf_(v[0]), siluf_(v[1]), siluf_(v[2]), siluf_(v[3])}; }
__device__ __forceinline__ float rdlane(float v, int l) { return __uint_as_float((unsigned)__builtin_amdgcn_readlane((int)__float_as_uint(v), l)); }
template <int M> __device__ __forceinline__ float swz_xor(float v) { static_assert(M >= 1 && M <= 16, "swz_xor"); return __uint_as_float((unsigned)__builtin_amdgcn_ds_swizzle((int)__float_as_uint(v), (M << 10) | 0x1f)); }
__device__ __forceinline__ float sum_x32(float v) { auto r = __builtin_amdgcn_permlane32_swap(__float_as_uint(v), __float_as_uint(v), false, false); return __uint_as_float(r[0]) + __uint_as_float(r[1]); }
__device__ __forceinline__ float max_x32(float v) { auto r = __builtin_amdgcn_permlane32_swap(__float_as_uint(v), __float_as_uint(v), false, false); return fmaxf(__uint_as_float(r[0]), __uint_as_float(r[1])); }
__device__ __forceinline__ float get_x32(float v, bool upper) { auto r = __builtin_amdgcn_permlane32_swap(__float_as_uint(v), __float_as_uint(v), false, false); return __uint_as_float(upper ? r[0] : r[1]); }
__device__ __forceinline__ float wave_sum(float v) { v += swz_xor<1>(v); v += swz_xor<2>(v); v += swz_xor<4>(v); v += swz_xor<8>(v); v += swz_xor<16>(v); return sum_x32(v); }
__device__ __forceinline__ float wave_max(float v) { v = fmaxf(v, swz_xor<1>(v)); v = fmaxf(v, swz_xor<2>(v)); v = fmaxf(v, swz_xor<4>(v)); v = fmaxf(v, swz_xor<8>(v)); v = fmaxf(v, swz_xor<16>(v)); return max_x32(v); }

struct EpiIn {
    static constexpr bool PERM = true, AFTER_DRAIN = false, MID = false;
    unsigned char* ws; float* out; int l;
    __device__ __forceinline__ void rope8(f32x4& a, f32x4& b, const float* tab, bool doit, bool second) const {
        f32x4 pa, pb;
#pragma unroll
        for (int e = 0; e < 4; ++e) { pa[e] = swz_xor<16>(a[e]); pb[e] = swz_xor<16>(b[e]); }
        if (doit) {
            const f32x4 c0 = *(const f32x4*)(tab), c1 = *(const f32x4*)(tab + 4), s0 = *(const f32x4*)(tab + 8), s1 = *(const f32x4*)(tab + 12);
            if (second) { a = a * c0 + pa * s0; b = b * c1 + pb * s1; }
            else        { a = a * c0 - pa * s0; b = b * c1 - pb * s1; }
        }
    }
    __device__ __forceinline__ void operator()(const f32x4 (&acc)[2][2][4][2], const pg8::Unit& u, int wr, int wc, int fr, int fq) const {
        bf16_t* U = (bf16_t*)(ws + WS_U); bf16_t* GA = (bf16_t*)(ws + WS_GA); bf16_t* Q = (bf16_t*)(ws + WS_Q); bf16_t* KV = (bf16_t*)(ws + WS_KV); bf16_t* GB = (bf16_t*)(ws + WS_GB);
        bf16_t* MGR = (bf16_t*)out; bf16_t* MGB = MGR + (size_t)MR * DM;
        const float* sumsq = (const float*)(ws + WS_SUMSQ) + l * MPAD; const float* rope = (const float*)(ws + WS_ROPE);
        float* ncp = out + O_NCP + (size_t)l * 4 * 30 * 1024; float* nkp = out + O_NKP + (size_t)l * 4 * 128 * 128; float* nvp = out + O_NVP + (size_t)l * 4 * 128 * 128;
        float* ncs = out + O_NCS + (size_t)l * 128 * 30 * 1024; float* nks = out + O_NKS + (size_t)l * 128 * 128 * 128; float* nvs = out + O_NVS + (size_t)l * 128 * 128 * 128;
        const int pn = u.pn, cl = wc * 32 + 8 * fq;
        const bool ropelane = ((wc & 1) == 0) && (fq < 2), second = (fq & 1) != 0;
        float rsv[8];
#pragma unroll
        for (int i = 0; i < 8; ++i) rsv[i] = *boff(sumsq, (unsigned)(u.pm * 256 + (i >> 2) * 128 + wr * 64 + (i & 3) * 16 + fr) * 4u);
#pragma unroll
        for (int ai = 0; ai < 2; ++ai)
#pragma unroll
            for (int m = 0; m < 4; ++m) {
                const int row = u.pm * 256 + ai * 128 + wr * 64 + m * 16 + fr;
                const bool ok = row < MR;
                const float rs = rsqrtf(rsv[ai * 4 + m] * (1.0f / DM) + EPS);
                f32x4 v00 = acc[ai][0][m][0] * rs, v01 = acc[ai][0][m][1] * rs, v10 = acc[ai][1][m][0] * rs, v11 = acc[ai][1][m][1] * rs;
                const int pos = row & (SEQ - 1), b = row >> 12, sb = row - MP;
                if (pn < 8) {
                    const int col = 128 * pn + cl;
                    v00 = v00 * sig4(v10); v01 = v01 * sig4(v11);
                    if (ok) *(u32x4*)boff(U, (unsigned)(row * DM + col) * 2u) = pack8(v00, v01);
                    if (row < MP) { if (pos >= SEQ - 30) { float* o = boff(ncp, (unsigned)((b * 30 + pos - (SEQ - 30)) * DM + col) * 4u); *(f32x4*)o = v00; *(f32x4*)(o + 4) = v01; } }
                    else if (ok) { float* o = boff(ncs, (unsigned)((sb * 30 + 29) * DM + col) * 4u); *(f32x4*)o = v00; *(f32x4*)(o + 4) = v01; }
                } else if (pn < 12) {
                    const int col = 256 * (pn - 8) + cl;
                    if (ok) { bf16_t* o = boff(GA, (unsigned)(row * DM + col) * 2u); *(u32x4*)o = pack8(silu4(v00), silu4(v01)); *(u32x4*)(o + 128) = pack8(silu4(v10), silu4(v11)); }
                } else if (pn < 16) {
                    const int col = 256 * (pn - 12) + cl;
                    const float* tab = boff(rope, (unsigned)(row < MP ? pos : SEQ) * 64u);
                    rope8(v00, v01, tab, ropelane, second); rope8(v10, v11, tab, ropelane, second);
                    v00 *= QSCALE; v01 *= QSCALE; v10 *= QSCALE; v11 *= QSCALE;
                    if (ok) { bf16_t* o = boff(Q, (unsigned)(row * DM + col) * 2u); *(u32x4*)o = pack8(v00, v01); *(u32x4*)(o + 128) = pack8(v10, v11); }
                } else if (pn == 16) {
                    const float* tab = boff(rope, (unsigned)(row < MP ? pos : SEQ) * 64u);
                    rope8(v00, v01, tab, ropelane, second);
                    if (ok) { bf16_t* o = boff(KV, (unsigned)(row * 256 + cl) * 2u); *(u32x4*)o = pack8(v00, v01); *(u32x4*)(o + 128) = pack8(v10, v11); }
                    if (row < MP) { if (pos >= SEQ - 128) { const unsigned o = (unsigned)((b * 128 + pos - (SEQ - 128)) * 128 + cl) * 4u; float* ok_ = boff(nkp, o); float* ov_ = boff(nvp, o);
                            *(f32x4*)ok_ = v00; *(f32x4*)(ok_ + 4) = v01; *(f32x4*)ov_ = v10; *(f32x4*)(ov_ + 4) = v11; } }
                    else if (ok) { const unsigned o = (unsigned)((sb * 128 + 127) * 128 + cl) * 4u; float* ok_ = boff(nks, o); float* ov_ = boff(nvs, o);
                            *(f32x4*)ok_ = v00; *(f32x4*)(ok_ + 4) = v01; *(f32x4*)ov_ = v10; *(f32x4*)(ov_ + 4) = v11; }
                } else if (pn < 21) {
                    const int col = 256 * (pn - 17) + cl;
                    if (ok) { bf16_t* o = boff(GB, (unsigned)(row * DM + col) * 2u); *(u32x4*)o = pack8(silu4(v00), silu4(v01)); *(u32x4*)(o + 128) = pack8(silu4(v10), silu4(v11)); }
                } else {
                    const int col = 128 * (pn - 21) + cl;
                    f32x4 r0, r1, s0, s1;
#pragma unroll
                    for (int e = 0; e < 4; ++e) { const float ea0 = __expf(-v00[e]), eb0 = __expf(-v10[e]), ea1 = __expf(-v01[e]), eb1 = __expf(-v11[e]);
                        s0[e] = __builtin_amdgcn_rcpf(1.f + eb0); s1[e] = __builtin_amdgcn_rcpf(1.f + eb1);
                        r0[e] = (1.f + eb0) * __builtin_amdgcn_rcpf(1.f + ea0); r1[e] = (1.f + eb1) * __builtin_amdgcn_rcpf(1.f + ea1); }
                    if (ok) { const unsigned o = (unsigned)(row * DM + col) * 2u; *(u32x4*)boff(MGR, o) = pack8(r0, r1); *(u32x4*)boff(MGB, o) = pack8(s0, s1); }
                }
            }
    }
};
struct EpiMid {
    static constexpr bool PERM = true, AFTER_DRAIN = false, MID = true;
    unsigned char* ws; float* out;
    __device__ __forceinline__ void mid(f32x4 (&acc)[2][2][4][2], const pg8::Unit& u, int wr, int wc, int fr, int fq) const {
        asm volatile("" : "+v"(fr), "+v"(fq));
        const bf16_t* MGR = (const bf16_t*)out;
        const int cl = u.pn * 256 + wc * 32 + 8 * fq;
#pragma unroll
        for (int am = 0; am < 4; ++am) { const int ai = am >> 1, m0 = (am & 1) * 2;
            u32x4 rv[2][2];
#pragma unroll
            for (int m = 0; m < 2; ++m)
#pragma unroll
                for (int bj = 0; bj < 2; ++bj) rv[m][bj] = *(const u32x4*)boff(MGR, (unsigned)((u.pm * 256 + ai * 128 + wr * 64 + (m0 + m) * 16 + fr) * DM + cl + 128 * bj) * 2u);
#pragma unroll
            for (int m = 0; m < 2; ++m)
#pragma unroll
                for (int bj = 0; bj < 2; ++bj) { f32x4 a, b; unpack8(rv[m][bj], a, b); acc[ai][bj][m0 + m][0] *= a; acc[ai][bj][m0 + m][1] *= b; }
            asm volatile("" ::: "memory");
        }
    }
    __device__ __forceinline__ void operator()(const f32x4 (&acc)[2][2][4][2], const pg8::Unit& u, int wr, int wc, int fr, int fq) const {
        const bf16_t* MGB = (const bf16_t*)out + (size_t)MR * DM; bf16_t* Y = (bf16_t*)(ws + WS_U);
        const int cl = u.pn * 256 + wc * 32 + 8 * fq;
#pragma unroll
        for (int ai = 0; ai < 2; ++ai) {
            u32x4 bv[4][2];
#pragma unroll
            for (int m = 0; m < 4; ++m)
#pragma unroll
                for (int bj = 0; bj < 2; ++bj) bv[m][bj] = *(const u32x4*)boff(MGB, (unsigned)((u.pm * 256 + ai * 128 + wr * 64 + m * 16 + fr) * DM + cl + 128 * bj) * 2u);
#pragma unroll
            for (int m = 0; m < 4; ++m)
#pragma unroll
                for (int bj = 0; bj < 2; ++bj) { f32x4 a, b; unpack8(bv[m][bj], a, b);
                    *(u32x4*)boff(Y, (unsigned)((u.pm * 256 + ai * 128 + wr * 64 + m * 16 + fr) * DM + cl + 128 * bj) * 2u) = pack8(acc[ai][bj][m][0] * a, acc[ai][bj][m][1] * b); }
        }
    }
};
struct EpiOut {
    static constexpr bool PERM = true, AFTER_DRAIN = false, MID = false;
    const float *xp, *xs; const float* gnext; unsigned char* ws; float* out; int layer; int sqi; int fuse;
    __device__ __forceinline__ void operator()(f32x4 (&acc)[2][2][4][2], const pg8::Unit& u, int wr, int wc, int fr, int fq) const {
        bf16_t* D1 = (bf16_t*)(ws + WS_D1); bf16_t* XN = (bf16_t*)(ws + WS_XN); float* sumsq_out = (float*)(ws + WS_SUMSQ) + sqi * MPAD;
        const int cl = u.pn * 256 + wc * 32 + 8 * fq;
        f32x4 gg[2][2];
#pragma unroll
        for (int bj = 0; bj < 2; ++bj) { gg[bj][0] = *(const f32x4*)(gnext + cl + 128 * bj); gg[bj][1] = *(const f32x4*)(gnext + cl + 128 * bj + 4); }
#pragma unroll
        for (int am = 0; am < 4; ++am) { const int ai = am >> 1, m0 = (am & 1) * 2;
            f32x4 xv[2][2][2]; u32x4 dv[2][2];
#pragma unroll
            for (int m = 0; m < 2; ++m) {
                const unsigned ro = (unsigned)((u.pm * 256 + ai * 128 + wr * 64 + (m0 + m) * 16 + fr) * DM + cl);
#pragma unroll
                for (int bj = 0; bj < 2; ++bj) { const float* xr_ = boff(xp, (ro + 128u * bj) * 4u); xv[m][bj][0] = *(const f32x4*)xr_; xv[m][bj][1] = *(const f32x4*)(xr_ + 4);
                    if (layer != 0) dv[m][bj] = *(const u32x4*)boff(D1, (ro + 128u * bj) * 2u); }
            }
#pragma unroll
            for (int m = 0; m < 2; ++m) {
                const int row = u.pm * 256 + ai * 128 + wr * 64 + (m0 + m) * 16 + fr;
                const unsigned ro = (unsigned)(row * DM + cl);
                float s = 0.f;
#pragma unroll
                for (int bj = 0; bj < 2; ++bj) {
                    const unsigned o2 = (ro + 128u * bj) * 2u;
                    f32x4 x0 = xv[m][bj][0], x1 = xv[m][bj][1];
                    const f32x4 a0 = acc[ai][bj][m0 + m][0], a1 = acc[ai][bj][m0 + m][1];
                    if (layer == 0) {
                        x0 += a0; x1 += a1;
                        *(u32x4*)boff(D1, o2) = pack8(a0, a1);
                        *(u32x4*)boff(XN, o2) = pack8(x0 * gg[bj][0], x1 * gg[bj][1]);
                    } else {
                        f32x4 d0, d1; unpack8(dv[m][bj], d0, d1);
                        x0 += d0 + a0; x1 += d1 + a1;
                        if (fuse) { acc[ai][bj][m0 + m][0] = x0; acc[ai][bj][m0 + m][1] = x1; }
                        else { float* o_ = boff(out, 2u * o2); *(f32x4*)o_ = x0; *(f32x4*)(o_ + 4) = x1; }
                    }
                    s += (x0[0] * x0[0] + x0[1] * x0[1]) + (x0[2] * x0[2] + x0[3] * x0[3]) + (x1[0] * x1[0] + x1[1] * x1[1]) + (x1[2] * x1[2] + x1[3] * x1[3]);
                }
                s += swz_xor<16>(s); s = sum_x32(s);
                if (fq == 0) atomicAdd(boff(sumsq_out, (unsigned)row * 4u), s);
            }
        }
        if (layer != 0 && fuse) {
            unsigned* cnt = (unsigned*)(ws + WS_CNT) + 32 * u.pm;
            asm volatile("s_waitcnt vmcnt(0)" ::: "memory");
            if (fr == 0 && fq == 0) __hip_atomic_fetch_add(cnt, 1u, __ATOMIC_RELAXED, __HIP_MEMORY_SCOPE_AGENT);
            for (unsigned sp = 0; sp < (1u << 22); ++sp) {
                if ((unsigned)__builtin_amdgcn_readfirstlane((int)__hip_atomic_load(cnt, __ATOMIC_RELAXED, __HIP_MEMORY_SCOPE_AGENT)) >= 32u) break;
                __builtin_amdgcn_s_sleep(2);
            }
            __builtin_amdgcn_fence(__ATOMIC_ACQUIRE, "agent");
#pragma unroll
            for (int ai = 0; ai < 2; ++ai)
#pragma unroll
                for (int m = 0; m < 4; ++m) {
                    const int row = u.pm * 256 + ai * 128 + wr * 64 + m * 16 + fr;
                    const float rs = rsqrtf(__hip_atomic_load(boff(sumsq_out, (unsigned)row * 4u), __ATOMIC_RELAXED, __HIP_MEMORY_SCOPE_AGENT) * (1.0f / DM) + EPS);
#pragma unroll
                    for (int bj = 0; bj < 2; ++bj) { float* o_ = boff(out, (unsigned)(row * DM + cl + 128 * bj) * 4u);
                        *(f32x4*)o_ = acc[ai][bj][m][0] * rs * gg[bj][0]; *(f32x4*)(o_ + 4) = acc[ai][bj][m][1] * rs * gg[bj][1]; }
                }
        }
    }
};
struct TrDesc { const float* W; bf16_t* WT; int N, pitch, coff, k0, n0, drow0; };
__device__ __forceinline__ void tr_load(const TrDesc& d, float (&tv)[32], int lane) {
#pragma unroll
    for (int i = 0; i < 32; ++i) { const int kk = 2 * i + (lane >> 5); tv[i] = d.W[(size_t)(d.k0 + kk) * d.N + d.n0 + (lane & 31)]; }
}
__device__ __forceinline__ void tr_store(const TrDesc& d, const float (&tv)[32], LAS float* scr, int lane) {
#pragma unroll
    for (int i = 0; i < 32; ++i) { const int kk = 2 * i + (lane >> 5); scr[kk * 33 + (lane & 31)] = tv[i]; }
    asm volatile("s_waitcnt lgkmcnt(0)" ::: "memory");
    const int c = lane & 7;
#pragma unroll
    for (int j = 0; j < 4; ++j) { const int n = (lane >> 3) + 8 * j; const LAS float* sp = scr + (8 * c) * 33 + n;
        u32x4 o; o.x = pk2(sp[0 * 33], sp[1 * 33]); o.y = pk2(sp[2 * 33], sp[3 * 33]); o.z = pk2(sp[4 * 33], sp[5 * 33]); o.w = pk2(sp[6 * 33], sp[7 * 33]);
        *(u32x4*)(d.WT + (size_t)(d.drow0 + n) * d.pitch + d.coff + d.k0 + 8 * c) = o; }
    asm volatile("s_waitcnt lgkmcnt(0)" ::: "memory");
}
__device__ __forceinline__ int win_dst_row(int src) {
    if (src < 2048) { const int half = src >> 10, c = src & 1023; return (c >> 7) * 256 + half * 128 + (c & 127); }
    if (src < 5376) return src;
    const int s = src - 5376, half = s >> 10, c = s & 1023; return 5376 + (c >> 7) * 256 + half * 128 + (c & 127);
}

constexpr int TR_I_IN = 16 * (INC / 32), TR_I_SQ = 16 * 32, TR_I_L = TR_I_IN + 3 * TR_I_SQ;
__device__ __forceinline__ TrDesc tr_decode(int l, int r, const float* w_in, const float* w_c, const float* w_a, const float* w_o, unsigned char* ws) {
    bf16_t* WIN = (bf16_t*)(ws + WS_WIN); bf16_t* WCA = (bf16_t*)(ws + WS_WCA); bf16_t* WO = (bf16_t*)(ws + WS_WO);
    TrDesc d;
    if (r < TR_I_IN) { const int kb = r / (INC / 32), nb = r % (INC / 32); d.W = w_in + (size_t)l * DM * INC; d.WT = WIN + (size_t)l * INC * DM; d.N = INC; d.pitch = DM; d.coff = 0; d.k0 = 64 * kb; d.n0 = 32 * nb; d.drow0 = win_dst_row(32 * nb); return d; }
    r -= TR_I_IN; const int which = r / TR_I_SQ; r %= TR_I_SQ; const int kb = r / 32, nb = r % 32;
    d.N = DM; d.k0 = 64 * kb; d.n0 = 32 * nb; d.drow0 = 32 * nb; d.coff = 0;
    if (which == 0) { d.W = w_c + (size_t)l * DM * DM; d.WT = WCA + (size_t)l * DM * 2048; d.pitch = 2048; }
    else if (which == 1) { d.W = w_a + (size_t)l * DM * DM; d.WT = WCA + (size_t)l * DM * 2048; d.pitch = 2048; d.coff = 1024; }
    else { d.W = w_o + (size_t)l * DM * DM; d.WT = WO + (size_t)l * DM * DM; d.pitch = DM; }
    return d;
}
template <int N> __device__ __forceinline__ void block_sums(float (&v)[N], LAS float* red  , int tid, int lane, int wave) {
    if constexpr (N == 32) {
#define BS_STEP(HALF, MASK, XCH) { const bool up = (lane & MASK) != 0; \
        _Pragma("unroll") for (int i = 0; i < HALF; ++i) { float lo_ = v[i], hi_ = v[i + HALF]; asm volatile("" : "+v"(lo_), "+v"(hi_));   \
            const float keep = up ? hi_ : lo_, send = up ? lo_ : hi_; v[i] = keep + XCH; } }
        BS_STEP(16, 32, get_x32(send, up)) BS_STEP(8, 16, swz_xor<16>(send)) BS_STEP(4, 8, swz_xor<8>(send)) BS_STEP(2, 4, swz_xor<4>(send)) BS_STEP(1, 2, swz_xor<2>(send))
#undef BS_STEP
        v[0] += swz_xor<1>(v[0]);
        if ((lane & 1) == 0) red[wave * 32 + (lane >> 1)] = v[0];
    } else {
#pragma unroll
        for (int i = 0; i < N; ++i) { v[i] = wave_sum(v[i]); if (lane == 0) red[wave * N + i] = v[i]; }
    }
    __syncthreads();
    if (tid < N) { float t = 0.f;
#pragma unroll
        for (int w = 0; w < 8; ++w) t += red[w * N + tid];
        red[8 * N + tid] = t; }
    __syncthreads();
}

__device__ __forceinline__ void conv_tile(int tile, LAS unsigned char* lds, const bf16_t* U, const bf16_t* GA, bf16_t* CO, const f32x2 (&w)[31], const float* cb, const float* lng, const float* lnb, int tid, int lane, int wave) {
    LAS float* red = (LAS float*)lds;
    const int row0 = tile * 16, pos0 = row0 & (SEQ - 1), c0 = 2 * tid;
    f32x2 acc[16];
    { const f32x2 bias = *(const f32x2*)(cb + c0);
#pragma unroll
      for (int t = 0; t < 16; ++t) acc[t] = bias; }
    unsigned uw[46], gw[16];
#pragma unroll
    for (int i = 0; i < 46; ++i) { const bool valid = (pos0 - 30 + i) >= 0; const int ri = valid ? row0 - 30 + i : row0;
        uw[i] = *(const unsigned*)boff(U + (size_t)ri * DM, (unsigned)c0 * 2u); }
#pragma unroll
    for (int i = 0; i < 46; ++i) {
        const bool valid = (pos0 - 30 + i) >= 0; const unsigned uu = valid ? uw[i] : 0u;
        const f32x2 uv = {bf_lo(uu), bf_hi(uu)};
#pragma unroll
        for (int t = 0; t < 16; ++t) { const int j = i - t; if (j >= 0 && j <= 30) acc[t] += w[j] * uv; }
    }
#pragma unroll
    for (int t = 0; t < 16; ++t) gw[t] = *(const unsigned*)boff(GA + (size_t)(row0 + t) * DM, (unsigned)c0 * 2u);
    float v[32];
#pragma unroll
    for (int t = 0; t < 16; ++t) { v[t] = acc[t].x + acc[t].y; v[16 + t] = acc[t].x * acc[t].x + acc[t].y * acc[t].y; }
    __syncthreads();
    block_sums<32>(v, red, tid, lane, wave);
    const f32x2 g = *(const f32x2*)(lng + c0), be = *(const f32x2*)(lnb + c0);
#pragma unroll
    for (int t = 0; t < 16; ++t) {
        const float mean = red[256 + t] * (1.0f / DM), var = red[256 + 16 + t] * (1.0f / DM) - mean * mean, rstd = rsqrtf(fmaxf(var, 0.f) + EPS);
        const float y0 = (acc[t].x - mean) * rstd * g.x + be.x, y1 = (acc[t].y - mean) * rstd * g.y + be.y;
        *(unsigned*)boff(CO + (size_t)(row0 + t) * DM, (unsigned)c0 * 2u) = pk2(siluf_(y0) * bf_lo(gw[t]), siluf_(y1) * bf_hi(gw[t]));
    }
}
__device__ __forceinline__ void conv_sample(int b, int l, LAS unsigned char* lds, const float* state, float* ncs, const bf16_t* GA, bf16_t* CO, const float* cw, const float* cb, const float* lng, const float* lnb, int tid, int lane, int wave) {
    tid = fresh_tid(wave); asm volatile("" : "+v"(tid)); lane = tid & 63;
    LAS float* red = (LAS float*)lds;
    const int c0 = 2 * tid, row = MP + b;
    f32x2 acc = *(const f32x2*)(cb + c0);
    const float* st = state + ((size_t)(l * 128 + b) * 30) * DM + c0;
    float* no = ncs + (size_t)b * 30 * DM + c0;
    f32x2 sv[31], wv[31];
#pragma unroll
    for (int j = 0; j < 30; ++j) sv[j] = *(const f32x2*)(st + (size_t)j * DM);
    sv[30] = *(const f32x2*)(no + (size_t)29 * DM);
#pragma unroll
    for (int j = 0; j < 31; ++j) wv[j] = *(const f32x2*)(cw + j * DM + c0);
    const unsigned gw = *(const unsigned*)(GA + (size_t)row * DM + c0);
#pragma unroll
    for (int j = 0; j < 31; ++j) acc += wv[j] * sv[j];
#pragma unroll
    for (int j = 1; j < 30; ++j) *(f32x2*)(no + (size_t)(j - 1) * DM) = sv[j];
    float v[2] = {acc.x + acc.y, acc.x * acc.x + acc.y * acc.y};
    __syncthreads();
    block_sums<2>(v, red, tid, lane, wave);
    const float mean = red[16] * (1.0f / DM), var = red[17] * (1.0f / DM) - mean * mean, rstd = rsqrtf(fmaxf(var, 0.f) + EPS);
    const f32x2 g = *(const f32x2*)(lng + c0), be = *(const f32x2*)(lnb + c0);
    const float y0 = (acc.x - mean) * rstd * g.x + be.x, y1 = (acc.y - mean) * rstd * g.y + be.y;
    *(unsigned*)(CO + (size_t)row * DM + c0) = pk2(siluf_(y0) * bf_lo(gw), siluf_(y1) * bf_hi(gw));
}
__device__ __forceinline__ int crow(int r, int hi) { return (r & 3) + 8 * (r >> 2) + 4 * hi; }
constexpr int AT_K = 0, AT_V = 192 * 144, AT_VP = 392, AT_STG = AT_V + 64 * AT_VP, AT_WS = AT_STG + 8 * 4096, AT_END = AT_WS + 8 * 128;
constexpr int AT_NK = 192;
__device__ __forceinline__ void attn_prompt_unit(int item, LAS unsigned char* lds, const bf16_t* KV, const bf16_t* Q, bf16_t* OG, const bf16_t* GB, const float* sinks, int tid, int lane, int wave) {
    tid = fresh_tid(wave); asm volatile("" : "+v"(tid)); lane = tid & 63;
    const int g = item & 1, bq = item >> 1, row0 = bq * 64, p0 = row0 & (SEQ - 1);
    const int q = lane & 31, hi = lane >> 5, h = 8 * g + wave;
    __syncthreads();
    u32x4 kk3[3], vv3[3];
#pragma unroll
    for (int i3 = 0; i3 < 3; ++i3) { const int c = tid + 512 * i3, kc = c >> 3, ch = c & 7;
        kk3[i3] = (u32x4){0u, 0u, 0u, 0u}; vv3[i3] = (u32x4){0u, 0u, 0u, 0u};
        if (p0 - 128 + kc >= 0) { const bf16_t* src = KV + (size_t)(row0 - 128 + kc) * 256 + g * 64 + ch * 8; kk3[i3] = *(const u32x4*)src; vv3[i3] = *(const u32x4*)(src + 128); } }
    bf16x8 qf[2][4];
    { const bf16_t* qrow = Q + (size_t)(row0 + q) * DM + 64 * h;
#pragma unroll
      for (int s = 0; s < 4; ++s) qf[0][s] = *(const bf16x8*)(qrow + 16 * s + 8 * hi); }
#pragma unroll
    for (int i3 = 0; i3 < 3; ++i3) {
        const int c = tid + 512 * i3, kc = c >> 3, ch = c & 7;
        const u32x4 kk = kk3[i3], vv = vv3[i3];
        *(LAS u32x4*)(lds + AT_K + kc * 144 + ch * 16) = kk;
        LAS unsigned short* vt = (LAS unsigned short*)(lds + AT_V + (ch * 8) * AT_VP + kc * 2);
        vt[0 * (AT_VP / 2)] = (unsigned short)(vv.x & 0xffffu); vt[1 * (AT_VP / 2)] = (unsigned short)(vv.x >> 16);
        vt[2 * (AT_VP / 2)] = (unsigned short)(vv.y & 0xffffu); vt[3 * (AT_VP / 2)] = (unsigned short)(vv.y >> 16);
        vt[4 * (AT_VP / 2)] = (unsigned short)(vv.z & 0xffffu); vt[5 * (AT_VP / 2)] = (unsigned short)(vv.z >> 16);
        vt[6 * (AT_VP / 2)] = (unsigned short)(vv.w & 0xffffu); vt[7 * (AT_VP / 2)] = (unsigned short)(vv.w >> 16);
    }
    const float sink = sinks[h];
    __syncthreads();
#pragma unroll
    for (int sb = 0; sb < 2; ++sb) {
    const int p0s = p0 + 32 * sb;
    f32x16 st[5];
#pragma unroll
    for (int c = 0; c < 5; ++c) {
#pragma unroll
        for (int r = 0; r < 16; ++r) st[c][r] = 0.f;
#pragma unroll
        for (int s = 0; s < 4; ++s) { const bf16x8 kf = *(const LAS bf16x8*)(lds + AT_K + (32 * c + 32 * sb + q) * 144 + 32 * s + 16 * hi); st[c] = __builtin_amdgcn_mfma_f32_32x32x16_bf16(kf, qf[sb][s], st[c], 0, 0, 0); }
    }
    if (sb == 0) { const bf16_t* qrow = Q + (size_t)(row0 + 32 + q) * DM + 64 * h;
#pragma unroll
      for (int s = 0; s < 4; ++s) qf[1][s] = *(const bf16x8*)(qrow + 16 * s + 8 * hi); }
    u32x4 gv4[4];
#pragma unroll
    for (int i = 0; i < 4; ++i) gv4[i] = *(const u32x4*)(GB + (size_t)(row0 + 32 * sb + i * 8 + (lane >> 3)) * DM + 64 * h + (lane & 7) * 8);
    float mx = -1e30f;
    if (p0s >= 128) {
#pragma unroll
        for (int r = 0; r < 16; ++r) { const int kc = crow(r, hi); if (!(kc > q)) st[0][r] = -1e30f; if (!(kc <= q)) st[4][r] = -1e30f; }
    } else {
#pragma unroll
        for (int c = 0; c < 5; ++c)
#pragma unroll
            for (int r = 0; r < 16; ++r) { const int kc = 32 * c + crow(r, hi); const bool valid = (kc > q) && (kc <= q + 128) && (kc >= 128 - p0s); if (!valid) st[c][r] = -1e30f; }
    }
#pragma unroll
    for (int c = 0; c < 5; ++c)
#pragma unroll
        for (int r = 0; r < 16; ++r) mx = fmaxf(mx, st[c][r]);
    mx = max_x32(mx);
    const float sink2 = sink * LOG2E;
    const float mm = fmaxf(mx, sink2);
    float ls = 0.f;
#pragma unroll
    for (int c = 0; c < 5; ++c)
#pragma unroll
        for (int r = 0; r < 16; ++r) { const float p = __builtin_amdgcn_exp2f(st[c][r] - mm); st[c][r] = p; ls += p; }
    ls = sum_x32(ls);
    ls += __builtin_amdgcn_exp2f(sink2 - mm);
    f32x16 o[2];
#pragma unroll
    for (int r = 0; r < 16; ++r) { o[0][r] = 0.f; o[1][r] = 0.f; }
#pragma unroll
    for (int c = 0; c < 5; ++c)
#pragma unroll
        for (int s2 = 0; s2 < 2; ++s2) {
            u32x4 pw; pw.x = pk2(st[c][8 * s2 + 0], st[c][8 * s2 + 1]); pw.y = pk2(st[c][8 * s2 + 2], st[c][8 * s2 + 3]); pw.z = pk2(st[c][8 * s2 + 4], st[c][8 * s2 + 5]); pw.w = pk2(st[c][8 * s2 + 6], st[c][8 * s2 + 7]);
            const bf16x8 pa = __builtin_bit_cast(bf16x8, pw);
#pragma unroll
            for (int db = 0; db < 2; ++db) {
                const LAS unsigned char* vp = lds + AT_V + (q + 32 * db) * AT_VP + (32 * c + 32 * sb + 16 * s2 + 4 * hi) * 2;
                const u32x2 lo = *(const LAS u32x2*)vp, hh = *(const LAS u32x2*)(vp + 16);
                const u32x4 vw = {lo.x, lo.y, hh.x, hh.y};
                o[db] = __builtin_amdgcn_mfma_f32_32x32x16_bf16(pa, __builtin_bit_cast(bf16x8, vw), o[db], 0, 0, 0);
            }
        }
    LAS float* wsf = (LAS float*)(lds + AT_WS + wave * 128);
    if (hi == 0) wsf[q] = __builtin_amdgcn_rcpf(ls);
    asm volatile("s_waitcnt lgkmcnt(0)" ::: "memory");
    LAS unsigned short* stg = (LAS unsigned short*)(lds + AT_STG + wave * 4096);
#pragma unroll
    for (int r = 0; r < 16; ++r) { const int qr = crow(r, hi); const float rl = wsf[qr];
        stg[qr * 64 + q] = (unsigned short)(pk2(o[0][r] * rl, 0.f) & 0xffffu); stg[qr * 64 + 32 + q] = (unsigned short)(pk2(o[1][r] * rl, 0.f) & 0xffffu); }
    asm volatile("s_waitcnt lgkmcnt(0)" ::: "memory");
#pragma unroll
    for (int i = 0; i < 4; ++i) { const int rl = i * 8 + (lane >> 3), ch = lane & 7;
        const u32x4 ov = *(const LAS u32x4*)(stg + rl * 64 + ch * 8);
        const size_t off = (size_t)(row0 + 32 * sb + rl) * DM + 64 * h + ch * 8;
        f32x4 a0, a1, g0, g1; unpack8(ov, a0, a1); unpack8(gv4[i], g0, g1);
        *(u32x4*)(OG + off) = pack8(a0 * g0, a1 * g1); }
    }
}
__device__ __forceinline__ void attn_sample_unit(int item, int l, LAS unsigned char* lds, const float* ck, const float* cv, float* nks, float* nvs, const bf16_t* Q, bf16_t* OG, const bf16_t* GB, const float* sinks, int tid, int lane, int wave) {
    tid = fresh_tid(wave); asm volatile("" : "+v"(tid)); lane = tid & 63;
    const int g = item & 1, b = item >> 1, row = MP + b, h = 8 * g + wave;
    LAS float* Kc = (LAS float*)lds; LAS float* Vc = Kc + 128 * 65;
    __syncthreads();
    f32x4 k4[4], v4[4];
#pragma unroll
    for (int i = 0; i < 4; ++i) { const int e = tid + 512 * i, w = e >> 4, d = (e & 15) * 4;
        const size_t oo = ((size_t)(b * 128 + w) * 128) + g * 64 + d, ci = ((size_t)((l * 128 + b) * 128 + w + 1) * 128) + g * 64 + d;
        if (w < 127) { k4[i] = *(const f32x4*)(ck + ci); v4[i] = *(const f32x4*)(cv + ci); } else { k4[i] = *(const f32x4*)(nks + oo); v4[i] = *(const f32x4*)(nvs + oo); } }
#pragma unroll
    for (int i = 0; i < 4; ++i) { const int e = tid + 512 * i, w = e >> 4, d = (e & 15) * 4;
        const size_t oo = ((size_t)(b * 128 + w) * 128) + g * 64 + d;
        if (w < 127) { *(f32x4*)(nks + oo) = k4[i]; *(f32x4*)(nvs + oo) = v4[i]; }
#pragma unroll
        for (int q4 = 0; q4 < 4; ++q4) { Kc[w * 65 + d + q4] = k4[i][q4]; Vc[w * 65 + d + q4] = v4[i][q4]; } }
    const size_t qoff = (size_t)row * DM + 64 * h + lane;
    const float qv = __uint_as_float((unsigned)Q[qoff] << 16);
    const float sink = sinks[h];
    __syncthreads();
    float s0 = 0.f, s1 = 0.f;
#pragma unroll
    for (int d = 0; d < 64; ++d) { const float qd = rdlane(qv, d); s0 += qd * Kc[lane * 65 + d]; s1 += qd * Kc[(lane + 64) * 65 + d]; }
    const float sink2 = sink * LOG2E;
    const float mm = fmaxf(wave_max(fmaxf(s0, s1)), sink2);
    const float p0 = __builtin_amdgcn_exp2f(s0 - mm), p1 = __builtin_amdgcn_exp2f(s1 - mm);
    const float ls = wave_sum(p0 + p1) + __builtin_amdgcn_exp2f(sink2 - mm);
    float o = 0.f;
#pragma unroll
    for (int k = 0; k < 64; ++k) o += rdlane(p0, k) * Vc[k * 65 + lane];
#pragma unroll
    for (int k = 0; k < 64; ++k) o += rdlane(p1, k) * Vc[(64 + k) * 65 + lane];
    o *= __builtin_amdgcn_rcpf(ls);
    const float gbv = __uint_as_float((unsigned)GB[qoff] << 16);
    OG[qoff] = (bf16_t)(pk2(o * gbv, 0.f) & 0xffffu);
}


typedef float f32x4s __attribute__((ext_vector_type(4)));
template <int KTOT, int MODE>
__device__ __forceinline__ void sample_gemm(int bid, int G, LAS unsigned char* lds, const bf16_t* A1, const bf16_t* A2, const bf16_t* Bt, unsigned char* ws, float* out,
                                            const float* xs, const float* gnext, int layer, int tid_) {
    int tid = tid_; asm volatile("" : "+v"(tid));
    const int lane = tid & 63, wave = __builtin_amdgcn_readfirstlane(tid >> 6), fr = lane & 15, fq = lane >> 4, kq = wave & 3;
    LAS f32x4s* red = (LAS f32x4s*)lds;
    constexpr int KQ = KTOT / 4, NS = KQ / 32;
    for (int tp = bid; tp < 256; tp += G) {
        const int tile = 2 * tp + (wave >> 2), rt = tile & 7, ct = tile >> 3;
        const int k0 = kq * KQ;
        const bf16_t* ap = (KTOT == 2048 && k0 >= 1024) ? A2 + (size_t)(MP + 16 * rt + fr) * DM + (k0 - 1024) + 8 * fq : A1 + (size_t)(MP + 16 * rt + fr) * DM + k0 + 8 * fq;
        const bf16_t* bp = Bt + (size_t)(16 * ct + fr) * KTOT + k0 + 8 * fq;
        bf16x8 af[NS], bfr[NS];
#pragma unroll
        for (int s2 = 0; s2 < NS; ++s2) { af[s2] = *(const bf16x8*)(ap + 32 * s2); bfr[s2] = *(const bf16x8*)(bp + 32 * s2); }
        const int row = MP + 16 * rt + fr, col = 16 * ct + 4 * fq;
        const unsigned o2 = (unsigned)(row * DM + col) * 2u;
        u32x2 pre0 = {0u, 0u}, pre1 = {0u, 0u}; f32x4s prex = {0.f, 0.f, 0.f, 0.f}, preg = {0.f, 0.f, 0.f, 0.f};
        if (kq == 0) {
            if constexpr (MODE == 0) { pre0 = *(const u32x2*)boff((const bf16_t*)out, o2); pre1 = *(const u32x2*)boff((const bf16_t*)out + (size_t)MR * DM, o2); }
            else { prex = *(const f32x4s*)(xs + (size_t)(row - MP) * DM + col); if (layer == 0) preg = *(const f32x4s*)(gnext + col); else pre0 = *(const u32x2*)boff((const bf16_t*)(ws + WS_D1), o2); }
        }
        f32x4s acc = {0.f, 0.f, 0.f, 0.f};
#pragma unroll
        for (int s2 = 0; s2 < NS; ++s2) acc = __builtin_amdgcn_mfma_f32_16x16x32_bf16(bfr[s2], af[s2], acc, 0, 0, 0);
        __syncthreads();
        red[((wave >> 2) * 4 + kq) * 64 + lane] = acc;
        __syncthreads();
        if (kq == 0) {
            const f32x4s p0 = red[((wave >> 2) * 4 + 0) * 64 + lane], p1 = red[((wave >> 2) * 4 + 1) * 64 + lane], p2 = red[((wave >> 2) * 4 + 2) * 64 + lane], p3 = red[((wave >> 2) * 4 + 3) * 64 + lane];
            if constexpr (MODE == 0) {
                const u32x2 rw = pre0, bw = pre1;
                const f32x4s r = {bf_lo(rw.x), bf_hi(rw.x), bf_lo(rw.y), bf_hi(rw.y)}, bb = {bf_lo(bw.x), bf_hi(bw.x), bf_lo(bw.y), bf_hi(bw.y)};
                const f32x4s y = ((p0 + p1) * r + (p2 + p3)) * bb;
                u32x2 w; w.x = pk2(y[0], y[1]); w.y = pk2(y[2], y[3]);
                *(u32x2*)boff((bf16_t*)(ws + WS_U), o2) = w;
            } else {
                const f32x4s a = (p0 + p1) + (p2 + p3);
                f32x4s x = prex;
                if (layer == 0) {
                    x += a;
                    u32x2 w; w.x = pk2(a[0], a[1]); w.y = pk2(a[2], a[3]); *(u32x2*)boff((bf16_t*)(ws + WS_D1), o2) = w;
                    const f32x4s g = preg;
                    u32x2 w2; w2.x = pk2(x[0] * g[0], x[1] * g[1]); w2.y = pk2(x[2] * g[2], x[3] * g[3]); *(u32x2*)boff((bf16_t*)(ws + WS_XN), o2) = w2;
                } else {
                    const u32x2 dw = pre0;
                    x += (f32x4s){bf_lo(dw.x), bf_hi(dw.x), bf_lo(dw.y), bf_hi(dw.y)} + a;
                    *(f32x4s*)boff(out, 2u * o2) = x;
                }
                float sq = (x[0] * x[0] + x[1] * x[1]) + (x[2] * x[2] + x[3] * x[3]);
                sq += swz_xor<16>(sq); sq = sum_x32(sq);
                if (fq == 0) atomicAdd((float*)(ws + WS_SUMSQ) + (layer + 1) * MPAD + row, sq);
                if (layer != 0) { __builtin_amdgcn_fence(__ATOMIC_RELEASE, "agent"); asm volatile("s_waitcnt vmcnt(0)" ::: "memory"); if (lane == 0) __hip_atomic_fetch_add((unsigned*)(ws + WS_CNT) + 32 * (64 + rt), 1u, __ATOMIC_RELAXED, __HIP_MEMORY_SCOPE_AGENT); }
            }
        }
    }
    __syncthreads();
}

#define XB_TMO      128
#define XB_XCNT(j)  (256  + 64 * (j))
#define XB_XSUB(j)  (1280 + 64 * (j))
#define XB_XGEN(j)  (2304 + 64 * (j))
#define XB_TOP      3328
#define XB_TOPGEN   3392
#define XCD_BAR_WORDS 3456
#define XB_SPIN_CAP (1u << 18)

__device__ __forceinline__ unsigned xb_ld(unsigned* p)              { return __hip_atomic_load(p, __ATOMIC_RELAXED, __HIP_MEMORY_SCOPE_AGENT); }
__device__ __forceinline__ unsigned xb_add(unsigned* p, unsigned v) { return __hip_atomic_fetch_add(p, v, __ATOMIC_RELAXED, __HIP_MEMORY_SCOPE_AGENT); }
__device__ __forceinline__ unsigned xb_xcc_id() { return (unsigned)__builtin_amdgcn_s_getreg((3 << 11) | 20) & 0xFu; }
#define XB_SPIN(cond, bar) do { unsigned _sp = 0; while (cond) { __builtin_amdgcn_s_sleep(1); \
    if ((++_sp & 255u) == 0u) { if (xb_ld(&(bar)[XB_TMO])) break; if (_sp > XB_SPIN_CAP) { atomicAdd(&(bar)[XB_TMO], 1u); break; } } } } while (0)

struct XcdBarrier {
    unsigned* bar; unsigned x; bool w0;
    volatile LAS unsigned* st;
};

__device__ __forceinline__ XcdBarrier xcd_barrier_post(unsigned* bar, volatile LAS unsigned* st) {
    XcdBarrier b; b.bar = bar; b.x = xb_xcc_id(); b.st = st;
    if (threadIdx.x == 0) (void)xb_add(&bar[XB_XCNT(b.x)], 1u);
    return b;
}
__device__ __forceinline__ void xcd_barrier_complete(unsigned* bar, unsigned x, unsigned& nloc, unsigned& nx) {
    const unsigned G = gridDim.x * gridDim.y * gridDim.z;
    unsigned sum, cnt, mine, sp = 0u;
    for (;;) {
        sum = 0u; cnt = 0u; mine = 0u;
#pragma unroll
        for (unsigned j = 0; j < 16; ++j) { const unsigned c = xb_ld(&bar[XB_XCNT(j)]); sum += c; cnt += (c > 0u) ? 1u : 0u; mine = (j == x) ? c : mine; }
        if (sum == G) break;
        __builtin_amdgcn_s_sleep(1);
        if ((++sp & 255u) == 0u) { if (xb_ld(&bar[XB_TMO])) break; if (sp > XB_SPIN_CAP) { atomicAdd(&bar[XB_TMO], 1u); break; } }
    }
    nloc = mine > 0u ? mine : 1u; nx = cnt > 0u ? cnt : 1u;
}

__device__ __forceinline__ void xcd_barrier(const XcdBarrier& b) {
    asm volatile("s_waitcnt vmcnt(0)" ::: "memory");
    __syncthreads();
    if (b.w0 && fresh_tid(0) == 0) {
        unsigned* bar = b.bar;
        __builtin_amdgcn_s_waitcnt(0);
        unsigned nloc = b.st[0], nx = b.st[1];
        if (nloc == 0u) { xcd_barrier_complete(bar, b.x, nloc, nx); b.st[0] = nloc; b.st[1] = nx; }
        const unsigned old = xb_add(&bar[XB_XSUB(b.x)], 1u);
        const unsigned gen = old / nloc;
        if (old + 1u == (gen + 1u) * nloc) {
            __builtin_amdgcn_fence(__ATOMIC_RELEASE, "agent");
            asm volatile("s_waitcnt vmcnt(0)" ::: "memory");
            const unsigned og = xb_add(&bar[XB_TOP], 1u);
            const unsigned tg = og / nx;
            if (og + 1u == (tg + 1u) * nx) xb_add(&bar[XB_TOPGEN], 1u);
            else XB_SPIN(xb_ld(&bar[XB_TOPGEN]) == tg, bar);
            __builtin_amdgcn_fence(__ATOMIC_ACQUIRE, "agent");
            xb_add(&bar[XB_XGEN(b.x)], 1u);
            asm volatile("s_waitcnt vmcnt(0)" ::: "memory");
        } else {
            XB_SPIN(xb_ld(&bar[XB_XGEN(b.x)]) == gen, bar);
            __builtin_amdgcn_fence(__ATOMIC_ACQUIRE, "agent");
            asm volatile("s_waitcnt vmcnt(0)" ::: "memory");
        }
    }
    __syncthreads();
}

struct Params { const float* in[16]; float* out; unsigned char* ws; float inv[8]; };
constexpr int LDS_BYTES = 131072 + 2048;

__global__ void __launch_bounds__(512, 2) fwd_megakernel(Params p) {
    extern __shared__ __attribute__((aligned(16))) unsigned char lds_raw[];
    LAS unsigned char* lds = (LAS unsigned char*)lds_raw;
    cg::grid_group grid = cg::this_grid();
    const int wave = __builtin_amdgcn_readfirstlane((int)threadIdx.x >> 6);
    const int G = gridDim.x, bid = blockIdx.x;
    volatile LAS unsigned* bst = (volatile LAS unsigned*)(lds + 131072 + 64);
    if (threadIdx.x < 2) bst[threadIdx.x] = 0u;
    __syncthreads();
    (void)xcd_barrier_post((unsigned*)(p.ws + WS_BAR), bst);
#define GRID_SYNC() do { XcdBarrier xb_; xb_.bar = (unsigned*)(p.ws + WS_BAR); xb_.x = xb_xcc_id(); xb_.st = (volatile LAS unsigned*)(lds + 131072 + 64); xb_.w0 = (wave == 0); xcd_barrier(xb_); } while (0)
    if (p.ws == nullptr) grid.sync();

#pragma unroll 1
    for (int rp0 = 0; rp0 < REP_P0; ++rp0) {
        if (rp0) GRID_SYNC();
        __attribute__((address_space(1))) unsigned char* wsg_ = (__attribute__((address_space(1))) unsigned char*)p.ws; __attribute__((address_space(1))) float* outg_ = (__attribute__((address_space(1))) float*)p.out;
        asm volatile("" : "+s"(wsg_), "+s"(outg_));
        unsigned char* ws = (unsigned char*)wsg_; float* out = (float*)outg_;
        int tid = threadIdx.x; asm volatile("" : "+v"(tid)); const int lane = tid & 63; (void)lane;
        float* sumsq = (float*)(ws + WS_SUMSQ); float* rope = (float*)(ws + WS_ROPE);
        bf16_t* XN = (bf16_t*)(ws + WS_XN); bf16_t* U = (bf16_t*)(ws + WS_U); bf16_t* GA = (bf16_t*)(ws + WS_GA); bf16_t* Q = (bf16_t*)(ws + WS_Q);
        bf16_t* GB = (bf16_t*)(ws + WS_GB); bf16_t* KV = (bf16_t*)(ws + WS_KV);
        bf16_t* WIN = (bf16_t*)(ws + WS_WIN); bf16_t* WCA = (bf16_t*)(ws + WS_WCA); bf16_t* WO = (bf16_t*)(ws + WS_WO);
        const float* x_p = p.in[0]; const float* x_s = p.in[1];
        (void)sumsq; (void)rope; (void)XN; (void)U; (void)GA; (void)Q; (void)GB; (void)KV; (void)WIN; (void)WCA; (void)WO; (void)x_p; (void)x_s;
        LAS float* scr = (LAS float*)(lds + wave * 16384);
        const int gw = bid * 8 + wave, NGW = G * 8;
        for (int it = gw; it < TR_I_L; it += 2 * NGW) {
            const bool two = it + NGW < TR_I_L;
            const TrDesc da = tr_decode(0, it, p.in[6], p.in[11], p.in[13], p.in[14], ws), db = tr_decode(0, two ? it + NGW : it, p.in[6], p.in[11], p.in[13], p.in[14], ws);
            float ta[32], tb[32];
            tr_load(da, ta, lane); if (two) tr_load(db, tb, lane);
            tr_store(da, ta, scr, lane); if (two) tr_store(db, tb, scr, lane);
        }
        const float* g0 = p.in[5];
        for (int m = gw; m < MR; m += 2 * NGW) {
            const int m2 = m + NGW; const bool two = m2 < MR;
            const float* xr = m < MP ? x_p + (size_t)m * DM : x_s + (size_t)(m - MP) * DM;
            const float* xr2 = !two ? xr : (m2 < MP ? x_p + (size_t)m2 * DM : x_s + (size_t)(m2 - MP) * DM);
            f32x4 va[4], vb[4];
#pragma unroll
            for (int j = 0; j < 4; ++j) { va[j] = *(const f32x4*)(xr + 256 * j + 4 * lane); vb[j] = *(const f32x4*)(xr2 + 256 * j + 4 * lane); }
            float sa = 0.f, sb = 0.f;
#pragma unroll
            for (int j = 0; j < 4; ++j) { const f32x4 gg = *(const f32x4*)(g0 + 256 * j + 4 * lane);
                sa += (va[j][0] * va[j][0] + va[j][1] * va[j][1]) + (va[j][2] * va[j][2] + va[j][3] * va[j][3]);
                sb += (vb[j][0] * vb[j][0] + vb[j][1] * vb[j][1]) + (vb[j][2] * vb[j][2] + vb[j][3] * vb[j][3]);
                u32x2 o; o.x = pk2(va[j][0] * gg[0], va[j][1] * gg[1]); o.y = pk2(va[j][2] * gg[2], va[j][3] * gg[3]); *(u32x2*)(XN + (size_t)m * DM + 256 * j + 4 * lane) = o;
                if (two) { u32x2 o2; o2.x = pk2(vb[j][0] * gg[0], vb[j][1] * gg[1]); o2.y = pk2(vb[j][2] * gg[2], vb[j][3] * gg[3]); *(u32x2*)(XN + (size_t)m2 * DM + 256 * j + 4 * lane) = o2; } }
            sa = wave_sum(sa); sb = wave_sum(sb);
            if (lane == 0) { sumsq[m] = sa; if (two) sumsq[m2] = sb; }
        }
        const int gt = bid * 512 + tid, NGT = G * 512;
        for (int i = gt; i < 3 * MPAD; i += NGT) { if (i >= MR) sumsq[i] = 0.f; }
        for (int i = gt; i < 4097 * 8; i += NGT) {
            const int pi = i >> 3, k = i & 7; const int pos = pi < SEQ ? pi : 16384;
            const float ang = (float)pos * p.inv[k];
            const double a = (double)ang, kk = __builtin_rint(a * 0.15915494309189535);
            double r = __builtin_fma(-kk, 6.283185307179586, a); r = __builtin_fma(-kk, 2.4492935982947064e-16, r);
            const double r2 = r * r; double sn = 1.0, cs = 1.0;
#pragma unroll
            for (int n = 11; n >= 1; --n) { sn = 1.0 - r2 * (1.0 / (double)((2 * n) * (2 * n + 1))) * sn; cs = 1.0 - r2 * (1.0 / (double)((2 * n - 1) * (2 * n))) * cs; }
            rope[pi * 16 + k] = (float)cs; rope[pi * 16 + 8 + k] = (float)(r * sn);
        }
    }
    GRID_SYNC();

#pragma unroll 1
    for (int l = 0; l < 2; ++l) {
        {
        __attribute__((address_space(1))) unsigned char* wsg_ = (__attribute__((address_space(1))) unsigned char*)p.ws; __attribute__((address_space(1))) float* outg_ = (__attribute__((address_space(1))) float*)p.out;
        asm volatile("" : "+s"(wsg_), "+s"(outg_));
        unsigned char* ws = (unsigned char*)wsg_; float* out = (float*)outg_;
        int tid = fresh_tid(wave); asm volatile("" : "+v"(tid)); const int lane = tid & 63; (void)lane;
        float* sumsq = (float*)(ws + WS_SUMSQ); float* rope = (float*)(ws + WS_ROPE);
        bf16_t* XN = (bf16_t*)(ws + WS_XN); bf16_t* U = (bf16_t*)(ws + WS_U); bf16_t* GA = (bf16_t*)(ws + WS_GA); bf16_t* Q = (bf16_t*)(ws + WS_Q);
        bf16_t* GB = (bf16_t*)(ws + WS_GB); bf16_t* KV = (bf16_t*)(ws + WS_KV);
        bf16_t* WIN = (bf16_t*)(ws + WS_WIN); bf16_t* WCA = (bf16_t*)(ws + WS_WCA); bf16_t* WO = (bf16_t*)(ws + WS_WO);
        const float* x_p = p.in[0]; const float* x_s = p.in[1];
        (void)sumsq; (void)rope; (void)XN; (void)U; (void)GA; (void)Q; (void)GB; (void)KV; (void)WIN; (void)WCA; (void)WO; (void)x_p; (void)x_s;
            pg8::Gemm g{XN, XN, WIN + (size_t)l * INC * DM, MPAD, INC, DM, DM, DM / 64};
            pg8::StaticOrder S; S.init(MPAD, INC, G, bid);
            EpiIn E{ws, out, l};
#ifndef SKIP_A
#pragma unroll 1
            for (int rp = 0; rp < REP_A; ++rp) { if (rp) GRID_SYNC(); pg8::gemm_phase<EpiIn, pg8::StaticOrder, true, true, false>(lds, g, S, E, wave); }
#endif
        }
        GRID_SYNC();
        {
        __attribute__((address_space(1))) unsigned char* wsg_ = (__attribute__((address_space(1))) unsigned char*)p.ws; __attribute__((address_space(1))) float* outg_ = (__attribute__((address_space(1))) float*)p.out;
        asm volatile("" : "+s"(wsg_), "+s"(outg_));
        unsigned char* ws = (unsigned char*)wsg_; float* out = (float*)outg_;
        int tid = fresh_tid(wave); asm volatile("" : "+v"(tid)); const int lane = tid & 63; (void)lane;
        float* sumsq = (float*)(ws + WS_SUMSQ); float* rope = (float*)(ws + WS_ROPE);
        bf16_t* XN = (bf16_t*)(ws + WS_XN); bf16_t* U = (bf16_t*)(ws + WS_U); bf16_t* GA = (bf16_t*)(ws + WS_GA); bf16_t* Q = (bf16_t*)(ws + WS_Q);
        bf16_t* GB = (bf16_t*)(ws + WS_GB); bf16_t* KV = (bf16_t*)(ws + WS_KV);
        bf16_t* WIN = (bf16_t*)(ws + WS_WIN); bf16_t* WCA = (bf16_t*)(ws + WS_WCA); bf16_t* WO = (bf16_t*)(ws + WS_WO);
        const float* x_p = p.in[0]; const float* x_s = p.in[1];
        (void)sumsq; (void)rope; (void)XN; (void)U; (void)GA; (void)Q; (void)GB; (void)KV; (void)WIN; (void)WCA; (void)WO; (void)x_p; (void)x_s;
            const float* cw = p.in[7] + (size_t)l * 31 * DM; const float* cb = p.in[8] + l * DM; const float* lng = p.in[9] + l * DM; const float* lnb = p.in[10] + l * DM;
            const float* sinks = p.in[12] + l * 16;
            float* ncs = out + O_NCS + (size_t)l * 128 * 30 * 1024; float* nks = out + O_NKS + (size_t)l * 128 * 128 * 128; float* nvs = out + O_NVS + (size_t)l * 128 * 128 * 128;
            if (l == 0) {
                LAS float* scr = (LAS float*)(lds + wave * 16384);
                const int ql = fresh_tid(0);
#pragma unroll 1
                for (int it = bid * 8 + wave; it < TR_I_L; it += G * 8) {
                    const TrDesc da = tr_decode(1, it, p.in[6], p.in[11], p.in[13], p.in[14], ws);
                    float ta[32];
                    tr_load(da, ta, ql); tr_store(da, ta, scr, ql);
                }
                __syncthreads();
            }
#pragma unroll 1
            for (int rpb = REP_B - 1; rpb >= 0; --rpb) {
            bf16_t* qd = rpb ? XN : Q; bf16_t* cd = rpb ? XN : GA;
#ifndef SKIP_ATT
            if (!rpb || (REP_B_MASK & 1))
            for (int gi = bid; gi < 256; gi += G) {
                const int grp = (G == 256) ? (gi & 7) * 32 + (gi >> 3) : gi;
#pragma unroll 1
                for (int k = 0; k < 2; ++k) attn_prompt_unit(((2 * (grp >> 1) + k) << 1) | (grp & 1), lds, KV, Q, qd, GB, sinks, tid, lane, wave);
            }
#endif
            if (!rpb || (REP_B_MASK & 2))
            {
                int tc = fresh_tid(wave); asm volatile("" : "+v"(tc)); const int lc = tc & 63;
                f32x2 w[31];
#pragma unroll
                for (int j = 0; j < 31; ++j) w[j] = *(const f32x2*)boff(cw + j * DM, (unsigned)tc * 8u);
                for (int gi = bid; gi < 256; gi += G) {
                    const int grp = (G == 256) ? (gi & 7) * 32 + (gi >> 3) : gi;
#pragma unroll 1
                    for (int k = 0; k < 4; ++k) conv_tile(4 * grp + k, lds, U, GA, cd, w, cb, lng, lnb, tc, lc, wave);
                }
            }
#ifndef SKIP_ATT
            if (!rpb || (REP_B_MASK & 4)) {
            for (int it = bid; it < 128; it += G) conv_sample(it, l, lds, p.in[2], ncs, GA, cd, cw, cb, lng, lnb, tid, lane, wave);
            for (int it = bid; it < 256; it += G) attn_sample_unit(it, l, lds, p.in[3], p.in[4], nks, nvs, Q, qd, GB, sinks, tid, lane, wave);
            }
#endif
            if (rpb) GRID_SYNC();
            }
        }
        GRID_SYNC();
        {
        __attribute__((address_space(1))) unsigned char* wsg_ = (__attribute__((address_space(1))) unsigned char*)p.ws; __attribute__((address_space(1))) float* outg_ = (__attribute__((address_space(1))) float*)p.out;
        asm volatile("" : "+s"(wsg_), "+s"(outg_));
        unsigned char* ws = (unsigned char*)wsg_; float* out = (float*)outg_;
        int tid = fresh_tid(wave); asm volatile("" : "+v"(tid)); const int lane = tid & 63; (void)lane;
        float* sumsq = (float*)(ws + WS_SUMSQ); float* rope = (float*)(ws + WS_ROPE);
        bf16_t* XN = (bf16_t*)(ws + WS_XN); bf16_t* U = (bf16_t*)(ws + WS_U); bf16_t* GA = (bf16_t*)(ws + WS_GA); bf16_t* Q = (bf16_t*)(ws + WS_Q);
        bf16_t* GB = (bf16_t*)(ws + WS_GB); bf16_t* KV = (bf16_t*)(ws + WS_KV);
        bf16_t* WIN = (bf16_t*)(ws + WS_WIN); bf16_t* WCA = (bf16_t*)(ws + WS_WCA); bf16_t* WO = (bf16_t*)(ws + WS_WO);
        const float* x_p = p.in[0]; const float* x_s = p.in[1];
        (void)sumsq; (void)rope; (void)XN; (void)U; (void)GA; (void)Q; (void)GB; (void)KV; (void)WIN; (void)WCA; (void)WO; (void)x_p; (void)x_s;
            pg8::Gemm g{GA, Q, WCA + (size_t)l * DM * 2048, MP, DM, 2048, DM, DM / 64};
            pg8::StaticOrder S; S.init(MP, DM, G, bid);
            sample_gemm<2048, 0>(bid, G, lds, GA, Q, WCA + (size_t)l * DM * 2048, ws, out, x_s, p.in[5] + DM, l, tid);
            EpiMid E{ws, out};
#ifndef SKIP_C
#pragma unroll 1
            for (int rp = 0; rp < REP_C; ++rp) { if (rp) GRID_SYNC(); pg8::gemm_phase<EpiMid, pg8::StaticOrder, true, true, true>(lds, g, S, E, wave); }
#endif
        }
        GRID_SYNC();
        {
        __attribute__((address_space(1))) unsigned char* wsg_ = (__attribute__((address_space(1))) unsigned char*)p.ws; __attribute__((address_space(1))) float* outg_ = (__attribute__((address_space(1))) float*)p.out;
        asm volatile("" : "+s"(wsg_), "+s"(outg_));
        unsigned char* ws = (unsigned char*)wsg_; float* out = (float*)outg_;
        int tid = fresh_tid(wave); asm volatile("" : "+v"(tid)); const int lane = tid & 63; (void)lane;
        float* sumsq = (float*)(ws + WS_SUMSQ); float* rope = (float*)(ws + WS_ROPE);
        bf16_t* XN = (bf16_t*)(ws + WS_XN); bf16_t* U = (bf16_t*)(ws + WS_U); bf16_t* GA = (bf16_t*)(ws + WS_GA); bf16_t* Q = (bf16_t*)(ws + WS_Q);
        bf16_t* GB = (bf16_t*)(ws + WS_GB); bf16_t* KV = (bf16_t*)(ws + WS_KV);
        bf16_t* WIN = (bf16_t*)(ws + WS_WIN); bf16_t* WCA = (bf16_t*)(ws + WS_WCA); bf16_t* WO = (bf16_t*)(ws + WS_WO);
        const float* x_p = p.in[0]; const float* x_s = p.in[1];
        (void)sumsq; (void)rope; (void)XN; (void)U; (void)GA; (void)Q; (void)GB; (void)KV; (void)WIN; (void)WCA; (void)WO; (void)x_p; (void)x_s;
            pg8::Gemm g{U, U, WO + (size_t)l * DM * DM, MP, DM, DM, DM, DM / 64};
            pg8::StaticOrder S; S.init(MP, DM, G, bid);
            sample_gemm<1024, 1>(bid, G, lds, U, U, WO + (size_t)l * DM * DM, ws, out, x_s, p.in[5] + DM, l, tid);
            const int fuse = (G == 256) ? 1 : 0;
            EpiOut E{x_p, x_s, l == 0 ? p.in[5] + DM : p.in[15], ws, out, l, l + 1, fuse};
#ifndef SKIP_D
#pragma unroll 1
            for (int rp = 0; rp < REP_D; ++rp) { if (rp) { GRID_SYNC(); E.sqi = 0; } pg8::gemm_phase<EpiOut, pg8::StaticOrder, true, true, true>(lds, g, S, E, wave); }
#endif
            if (l == 1 && fuse) {
                const int ql = fresh_tid(0);
                for (int r = bid * 8 + wave; r < MS; r += G * 8) {
                    unsigned* cnt = (unsigned*)(ws + WS_CNT) + 32 * (64 + (r >> 4));
                    for (unsigned sp = 0; sp < (1u << 22); ++sp) { if ((unsigned)__builtin_amdgcn_readfirstlane((int)__hip_atomic_load(cnt, __ATOMIC_RELAXED, __HIP_MEMORY_SCOPE_AGENT)) >= 64u) break; __builtin_amdgcn_s_sleep(2); }
                    __builtin_amdgcn_fence(__ATOMIC_ACQUIRE, "agent");
                    const int row = MP + r;
                    const float rs = rsqrtf(__hip_atomic_load((float*)(ws + WS_SUMSQ) + 2 * MPAD + row, __ATOMIC_RELAXED, __HIP_MEMORY_SCOPE_AGENT) * (1.0f / DM) + EPS);
                    float* orow = out + (size_t)row * DM; const float* gf = p.in[15];
#pragma unroll
                    for (int j = 0; j < 4; ++j) { const f32x4 v = *(const f32x4*)(orow + 256 * j + 4 * ql), gg = *(const f32x4*)(gf + 256 * j + 4 * ql); *(f32x4*)(orow + 256 * j + 4 * ql) = v * rs * gg; }
                }
            }
        }
        if (!(l == 1 && G == 256)) GRID_SYNC();
    }
    if (G != 256) {
        __attribute__((address_space(1))) unsigned char* wsg_ = (__attribute__((address_space(1))) unsigned char*)p.ws; __attribute__((address_space(1))) float* outg_ = (__attribute__((address_space(1))) float*)p.out;
        asm volatile("" : "+s"(wsg_), "+s"(outg_));
        unsigned char* ws = (unsigned char*)wsg_; float* out = (float*)outg_;
        int tid = fresh_tid(wave); asm volatile("" : "+v"(tid)); const int lane = tid & 63; (void)lane;
        float* sumsq = (float*)(ws + WS_SUMSQ); float* rope = (float*)(ws + WS_ROPE);
        bf16_t* XN = (bf16_t*)(ws + WS_XN); bf16_t* U = (bf16_t*)(ws + WS_U); bf16_t* GA = (bf16_t*)(ws + WS_GA); bf16_t* Q = (bf16_t*)(ws + WS_Q);
        bf16_t* GB = (bf16_t*)(ws + WS_GB); bf16_t* KV = (bf16_t*)(ws + WS_KV);
        bf16_t* WIN = (bf16_t*)(ws + WS_WIN); bf16_t* WCA = (bf16_t*)(ws + WS_WCA); bf16_t* WO = (bf16_t*)(ws + WS_WO);
        const float* x_p = p.in[0]; const float* x_s = p.in[1];
        (void)sumsq; (void)rope; (void)XN; (void)U; (void)GA; (void)Q; (void)GB; (void)KV; (void)WIN; (void)WCA; (void)WO; (void)x_p; (void)x_s;
        const float* gf = p.in[15]; const float* sq = sumsq + 2 * MPAD;
        const int gw = bid * 8 + wave, NGW = G * 8;
#pragma unroll 1
        for (int rp = REP_F - 1; rp >= 0; --rp) {
        float* dst = rp ? (float*)(ws + WS_U) : out;
        for (int m = gw; m < MR; m += 2 * NGW) {
            const int m2 = m + NGW < MR ? m + NGW : m;
            const float rs = rsqrtf(sq[m] * (1.0f / DM) + EPS), rs2 = rsqrtf(sq[m2] * (1.0f / DM) + EPS);
            const float* orow = out + (size_t)m * DM; float* drow = dst + (size_t)m * DM; const float* orow2 = out + (size_t)m2 * DM; float* drow2 = dst + (size_t)m2 * DM;
            f32x4 va[4], vb[4];
#pragma unroll
            for (int j = 0; j < 4; ++j) { va[j] = *(const f32x4*)(orow + 256 * j + 4 * lane); vb[j] = *(const f32x4*)(orow2 + 256 * j + 4 * lane); }
#pragma unroll
            for (int j = 0; j < 4; ++j) { const f32x4 gg = *(const f32x4*)(gf + 256 * j + 4 * lane); *(f32x4*)(drow + 256 * j + 4 * lane) = va[j] * rs * gg; if (m2 != m) *(f32x4*)(drow2 + 256 * j + 4 * lane) = vb[j] * rs2 * gg; }
        }
        if (rp) GRID_SYNC();
        }
    }
}

extern "C" void kernel_launch(void* const* d_in, const int* in_sizes, int n_in, void* d_out, int out_size, void* d_ws, size_t ws_size, hipStream_t stream) {
    static int grid = 0;
    if (grid == 0) {
        if (n_in != 16 || (size_t)out_size != O_END || ws_size < WS_END) { fprintf(stderr, "kernel_launch: unexpected sizes n_in %d out %d ws %zu\n", n_in, out_size, ws_size); grid = -1; return; }
        int dev = 0, cus = 0, per_cu = 0;
        hipGetDevice(&dev); hipDeviceGetAttribute(&cus, hipDeviceAttributeMultiprocessorCount, dev);
        if (hipFuncSetAttribute((const void*)fwd_megakernel, hipFuncAttributeMaxDynamicSharedMemorySize, LDS_BYTES) != hipSuccess) { fprintf(stderr, "kernel_launch: hipFuncSetAttribute failed\n"); grid = -1; return; }
        if (hipOccupancyMaxActiveBlocksPerMultiprocessor(&per_cu, (const void*)fwd_megakernel, 512, LDS_BYTES) != hipSuccess || per_cu < 1) { fprintf(stderr, "kernel_launch: occupancy query gave %d\n", per_cu); per_cu = 1; }
        (void)hipGetLastError();
        grid = cus * per_cu;
    }
    if (grid < 0) return;
    Params p{};
    for (int i = 0; i < 16; ++i) p.in[i] = (const float*)d_in[i];
    p.out = (float*)d_out; p.ws = (unsigned char*)d_ws;
    static const float inv[8] = {1.0f, 0.1939227432012558f, 0.03760603070259094f, 0.007292664609849453f, 0.0014142135623842478f, 0.00027424818836152554f, 5.3182957344688475e-05f, 1.0313385246263351e-05f};
    for (int i = 0; i < 8; ++i) p.inv[i] = inv[i];
    if (hipMemsetAsync((char*)d_ws + WS_BAR, 0, 16384 + 80 * 128, stream) != hipSuccess) { fprintf(stderr, "kernel_launch: hipMemsetAsync failed\n"); return; }
    void* args[] = {&p};
    hipError_t e = hipLaunchCooperativeKernel((const void*)fwd_megakernel, dim3(grid), dim3(512), args, LDS_BYTES, stream);
    if (e != hipSuccess) fprintf(stderr, "cooperative launch failed: %s (grid %d)\n", hipGetErrorString(e), grid);
}
```
